# Optimizing an MI355X kernel written in HIP

```python
import math
import jax
import jax.numpy as jnp
from jax import lax
import numpy as np

D_MODEL = 1024
BATCH = 8
SEQ = 4096
DEPTH = 4

N_EVEN = (DEPTH + 1) // 2
N_ODD = DEPTH // 2
Q_BLOCK = 128
RMS_EPS = 1e-6
NEG_INF = -1e30
FOX_HEADS = 8
FOX_HEAD_DIM = 64
FOX_WIDTH = FOX_HEADS * FOX_HEAD_DIM
FORGET_BIAS_MEAN = 3.0
MLA_HEADS = 8
MLA_NOPE_DIM = 64
MLA_ROPE_DIM = 32
MLA_V_DIM = 64
MLA_Q_RANK = 384
MLA_KV_RANK = 256
ROPE_THETA = 10000.0
EVEN_IN_WIDTH = 3 * FOX_WIDTH + FOX_HEADS + MLA_Q_RANK + MLA_KV_RANK + MLA_ROPE_DIM
EVEN_MIX_WIDTH = FOX_WIDTH + MLA_HEADS * MLA_V_DIM
DIFF_HEADS = 8
DIFF_HEAD_DIM = 64
DIFF_V_DIM = 2 * DIFF_HEAD_DIM
ODD_IN_WIDTH = 4 * DIFF_HEADS * DIFF_HEAD_DIM + DIFF_HEADS * DIFF_V_DIM
ODD_MIX_WIDTH = DIFF_HEADS * DIFF_V_DIM
D_FF = 2816
CONV_WIDTH = 3

kernel_name = 'hybrid_fox_mla_diffattn_convffn_trunk'


def _rms_norm(x, g):
    xf = x.astype(jnp.float32)
    y = xf * lax.rsqrt(jnp.mean(xf * xf, axis=-1, keepdims=True) + RMS_EPS)
    return (y * g.astype(jnp.float32)).astype(x.dtype)


def _rope_tables(seq, dim, dtype):
    inv = ROPE_THETA ** (-jnp.arange(0, dim, 2, dtype=jnp.float32) / dim)
    ang = jnp.arange(seq, dtype=jnp.float32)[:, None] * inv[None, :]
    return jnp.cos(ang).astype(dtype), jnp.sin(ang).astype(dtype)


def _apply_rope(x, cos, sin):
    x1, x2 = jnp.split(x, 2, axis=-1)
    return jnp.concatenate([x1 * cos - x2 * sin, x1 * sin + x2 * cos], axis=-1)


def _alibi_slopes(n):
    return 2.0 ** (-8.0 * jnp.arange(1, n + 1, dtype=jnp.float32) / n)


def _causal_mask(s0, seq):
    qpos = s0 + jnp.arange(Q_BLOCK)
    kpos = jnp.arange(seq)
    return qpos[:, None] >= kpos[None, :], (qpos[:, None] - kpos[None, :]).astype(jnp.float32)


def _merge_blocks(o):
    o = jnp.moveaxis(o, 0, 1)
    return o.reshape(o.shape[0], -1, o.shape[3] * o.shape[4])


def _fox_attention(q, k, v, log_f):
    seq, dh = q.shape[1], q.shape[3]
    c = jnp.cumsum(log_f, axis=1).transpose(0, 2, 1)
    scale = dh ** -0.5

    def block(i):
        s0 = i * Q_BLOCK
        qb = lax.dynamic_slice_in_dim(q, s0, Q_BLOCK, axis=1)
        cq = lax.dynamic_slice_in_dim(c, s0, Q_BLOCK, axis=2)
        mask, _ = _causal_mask(s0, seq)
        logits = jnp.einsum('bqhd,bkhd->bhqk', qb, k).astype(jnp.float32) * scale
        logits = logits + cq[..., :, None] - c[..., None, :]
        logits = jnp.where(mask, logits, NEG_INF)
        p = jax.nn.softmax(logits, axis=-1).astype(v.dtype)
        return jnp.einsum('bhqk,bkhd->bqhd', p, v)

    return _merge_blocks(lax.map(block, jnp.arange(seq // Q_BLOCK)))


def _mla_attention(q_nope, q_rope, k_nope, k_rope, v):
    seq = q_nope.shape[1]
    scale = (MLA_NOPE_DIM + MLA_ROPE_DIM) ** -0.5

    def block(i):
        s0 = i * Q_BLOCK
        qn = lax.dynamic_slice_in_dim(q_nope, s0, Q_BLOCK, axis=1)
        qr = lax.dynamic_slice_in_dim(q_rope, s0, Q_BLOCK, axis=1)
        mask, _ = _causal_mask(s0, seq)
        logits = (jnp.einsum('bqhd,bkhd->bhqk', qn, k_nope)
                  + jnp.einsum('bqhr,bkr->bhqk', qr, k_rope)).astype(jnp.float32) * scale
        logits = jnp.where(mask, logits, NEG_INF)
        p = jax.nn.softmax(logits, axis=-1).astype(v.dtype)
        return jnp.einsum('bhqk,bkhd->bqhd', p, v)

    return _merge_blocks(lax.map(block, jnp.arange(seq // Q_BLOCK)))


def _diff_attention(q1, q2, k1, k2, v, lam, slopes):
    seq, dh = q1.shape[1], q1.shape[3]
    scale = dh ** -0.5

    def block(i):
        s0 = i * Q_BLOCK
        q1b = lax.dynamic_slice_in_dim(q1, s0, Q_BLOCK, axis=1)
        q2b = lax.dynamic_slice_in_dim(q2, s0, Q_BLOCK, axis=1)
        mask, dist = _causal_mask(s0, seq)
        alibi = -slopes[:, None, None] * dist[None]
        l1 = jnp.einsum('bqhd,bkhd->bhqk', q1b, k1).astype(jnp.float32) * scale + alibi
        l2 = jnp.einsum('bqhd,bkhd->bhqk', q2b, k2).astype(jnp.float32) * scale + alibi
        p = (jax.nn.softmax(jnp.where(mask, l1, NEG_INF), axis=-1)
             - lam * jax.nn.softmax(jnp.where(mask, l2, NEG_INF), axis=-1)).astype(v.dtype)
        return jnp.einsum('bhqk,bkhd->bqhd', p, v)

    return _merge_blocks(lax.map(block, jnp.arange(seq // Q_BLOCK)))


def _even_mixer(h, w_in, b_forget, q_norm, w_uq, kv_norm, w_ukv, w_out, cos, sin):
    bsz, seq, _ = h.shape
    proj = h @ w_in
    cuts = np.cumsum([FOX_WIDTH, FOX_WIDTH, FOX_WIDTH, FOX_HEADS, MLA_Q_RANK, MLA_KV_RANK]).tolist()
    fq, fk, fv, fg, c_q, c_kv, k_r = jnp.split(proj, cuts, axis=-1)
    shp = (bsz, seq, FOX_HEADS, FOX_HEAD_DIM)
    log_f = jax.nn.log_sigmoid((fg + b_forget).astype(jnp.float32))
    fox_out = _fox_attention(fq.reshape(shp), fk.reshape(shp), fv.reshape(shp), log_f)
    q = (_rms_norm(c_q, q_norm) @ w_uq).reshape(bsz, seq, MLA_HEADS, MLA_NOPE_DIM + MLA_ROPE_DIM)
    q_nope, q_rope = jnp.split(q, [MLA_NOPE_DIM], axis=-1)
    q_rope = _apply_rope(q_rope, cos[:, None, :], sin[:, None, :])
    kv = (_rms_norm(c_kv, kv_norm) @ w_ukv).reshape(bsz, seq, MLA_HEADS, MLA_NOPE_DIM + MLA_V_DIM)
    k_nope, v = jnp.split(kv, [MLA_NOPE_DIM], axis=-1)
    k_rope = _apply_rope(k_r, cos, sin)
    mla_out = _mla_attention(q_nope, q_rope, k_nope, k_rope, v)
    return jnp.concatenate([fox_out, mla_out], axis=-1) @ w_out


def _odd_mixer(h, w_in, lq1, lk1, lq2, lk2, subln, w_out, slopes, lambda_init):
    bsz, seq, _ = h.shape
    qk_w = DIFF_HEADS * 2 * DIFF_HEAD_DIM
    q, k, v = jnp.split(h @ w_in, [qk_w, 2 * qk_w], axis=-1)
    q = q.reshape(bsz, seq, DIFF_HEADS, 2, DIFF_HEAD_DIM)
    k = k.reshape(bsz, seq, DIFF_HEADS, 2, DIFF_HEAD_DIM)
    v = v.reshape(bsz, seq, DIFF_HEADS, DIFF_V_DIM)
    f32 = jnp.float32
    lam = (jnp.exp(jnp.sum(lq1.astype(f32) * lk1.astype(f32)))
           - jnp.exp(jnp.sum(lq2.astype(f32) * lk2.astype(f32))) + lambda_init)
    o = _diff_attention(q[..., 0, :], q[..., 1, :], k[..., 0, :], k[..., 1, :], v, lam, slopes)
    o = o.reshape(bsz, seq, DIFF_HEADS, DIFF_V_DIM)
    o = _rms_norm(o, subln) * (1.0 - lambda_init)
    return o.reshape(bsz, seq, ODD_MIX_WIDTH) @ w_out


def _causal_dwconv(a, w, b):
    seq = a.shape[1]
    ap = jnp.pad(a, ((0, 0), (CONV_WIDTH - 1, 0), (0, 0)))
    out = b
    for tap in range(CONV_WIDTH):
        out = out + ap[:, tap:tap + seq] * w[tap]
    return out


def _conv_ffn(h, w_up, conv_w, conv_b, w_down):
    gate, val = jnp.split(h @ w_up, [D_FF], axis=-1)
    act = jax.nn.gelu(_causal_dwconv(gate, conv_w, conv_b), approximate=True)
    return (act * val) @ w_down


def setup_inputs(seed: int = 0) -> dict:
    key = jax.random.key(seed)
    ks = jax.random.split(key, 23)
    f32 = jnp.float32

    def nrm(k, shape, scale):
        return jax.random.normal(k, shape, f32) * scale

    def gain(k, shape):
        return 1.0 + nrm(k, shape, 0.1)

    return {
        'x': nrm(ks[0], (BATCH, SEQ, D_MODEL), 1.0),
        'norm_mix_pre': gain(ks[1], (DEPTH, D_MODEL)),
        'norm_mix_post': gain(ks[2], (DEPTH, D_MODEL)),
        'norm_ffn_pre': gain(ks[3], (DEPTH, D_MODEL)),
        'norm_ffn_post': gain(ks[4], (DEPTH, D_MODEL)),
        'even_w_in': nrm(ks[5], (N_EVEN, D_MODEL, EVEN_IN_WIDTH), D_MODEL ** -0.5),
        'even_b_forget': FORGET_BIAS_MEAN + nrm(ks[6], (N_EVEN, FOX_HEADS), 0.5),
        'even_q_norm': gain(ks[7], (N_EVEN, MLA_Q_RANK)),
        'even_w_uq': nrm(ks[8], (N_EVEN, MLA_Q_RANK, MLA_HEADS * (MLA_NOPE_DIM + MLA_ROPE_DIM)), MLA_Q_RANK ** -0.5),
        'even_kv_norm': gain(ks[9], (N_EVEN, MLA_KV_RANK)),
        'even_w_ukv': nrm(ks[10], (N_EVEN, MLA_KV_RANK, MLA_HEADS * (MLA_NOPE_DIM + MLA_V_DIM)), MLA_KV_RANK ** -0.5),
        'even_w_out': nrm(ks[11], (N_EVEN, EVEN_MIX_WIDTH, D_MODEL), EVEN_MIX_WIDTH ** -0.5),
        'odd_w_in': nrm(ks[12], (N_ODD, D_MODEL, ODD_IN_WIDTH), D_MODEL ** -0.5),
        'odd_lambda_q1': nrm(ks[13], (N_ODD, DIFF_HEAD_DIM), 0.1),
        'odd_lambda_k1': nrm(ks[14], (N_ODD, DIFF_HEAD_DIM), 0.1),
        'odd_lambda_q2': nrm(ks[15], (N_ODD, DIFF_HEAD_DIM), 0.1),
        'odd_lambda_k2': nrm(ks[16], (N_ODD, DIFF_HEAD_DIM), 0.1),
        'odd_subln': gain(ks[17], (N_ODD, DIFF_V_DIM)),
        'odd_w_out': nrm(ks[18], (N_ODD, ODD_MIX_WIDTH, D_MODEL), ODD_MIX_WIDTH ** -0.5),
        'ffn_w_up': nrm(ks[19], (DEPTH, D_MODEL, 2 * D_FF), D_MODEL ** -0.5),
        'ffn_conv_w': nrm(ks[20], (DEPTH, CONV_WIDTH, D_FF), CONV_WIDTH ** -0.5),
        'ffn_conv_b': nrm(ks[21], (DEPTH, D_FF), 0.02),
        'ffn_w_down': nrm(ks[22], (DEPTH, D_FF, D_MODEL), D_FF ** -0.5),
    }


def reference(x, norm_mix_pre, norm_mix_post, norm_ffn_pre, norm_ffn_post,
              even_w_in, even_b_forget, even_q_norm, even_w_uq, even_kv_norm, even_w_ukv, even_w_out,
              odd_w_in, odd_lambda_q1, odd_lambda_k1, odd_lambda_q2, odd_lambda_k2, odd_subln, odd_w_out,
              ffn_w_up, ffn_conv_w, ffn_conv_b, ffn_w_down):
    cos, sin = _rope_tables(x.shape[1], MLA_ROPE_DIM, x.dtype)
    slopes = _alibi_slopes(DIFF_HEADS)
    for layer in range(DEPTH):
        i = layer // 2
        h = _rms_norm(x, norm_mix_pre[layer])
        if layer % 2 == 0:
            m = _even_mixer(h, even_w_in[i], even_b_forget[i], even_q_norm[i], even_w_uq[i],
                            even_kv_norm[i], even_w_ukv[i], even_w_out[i], cos, sin)
        else:
            lambda_init = 0.8 - 0.6 * math.exp(-0.3 * layer)
            m = _odd_mixer(h, odd_w_in[i], odd_lambda_q1[i], odd_lambda_k1[i], odd_lambda_q2[i],
                           odd_lambda_k2[i], odd_subln[i], odd_w_out[i], slopes, lambda_init)
        x = x + _rms_norm(m, norm_mix_post[layer])
        h = _rms_norm(x, norm_ffn_pre[layer])
        f = _conv_ffn(h, ffn_w_up[layer], ffn_conv_w[layer], ffn_conv_b[layer], ffn_w_down[layer])
        x = x + _rms_norm(f, norm_ffn_post[layer])
    return x
```

```cpp
#include <hip/hip_runtime.h>
#include <hip/hip_cooperative_groups.h>
#include <cstdio>
#include <cstdint>
namespace cg = cooperative_groups;

#define LAS __attribute__((address_space(3)))
#ifndef KPF2
#define KPF2 true
#endif
typedef unsigned short bf16_t;
typedef short bf16x8 __attribute__((ext_vector_type(8)));
typedef short s16x4 __attribute__((ext_vector_type(4)));
typedef float f32x4 __attribute__((ext_vector_type(4)));
typedef float f32x16 __attribute__((ext_vector_type(16)));
typedef unsigned u32x4 __attribute__((ext_vector_type(4)));
typedef unsigned u32x2 __attribute__((ext_vector_type(2)));

constexpr int D_MODEL = 1024, BATCH = 8, SEQ = 4096, DEPTH = 4, MTOK = BATCH * SEQ;
constexpr int D_FF = 2816;
constexpr int EIN_N = 2216, EIN_NP = 2304;
constexpr int OIN_N = 3072;
constexpr float RMS_EPS = 1e-6f;
constexpr float LOG2E = 1.4426950408889634f;
constexpr float NEGBIG = -1e30f;
constexpr int C_FQ = 0, C_FK = 512, C_FV = 1024, C_FG = 1536, C_CQ = 1544, C_CKV = 1928, C_KR = 2184;

constexpr size_t MiB = 1u << 20;
constexpr size_t WS_RSTDQ = 128 * 1024, WS_RSTDKV = 256 * 1024;
constexpr size_t WS_CCUM = 1 * MiB, WS_KROPE = 2 * MiB, WS_COS = 4 * MiB, WS_SIN = 4 * MiB + 512 * 1024;
constexpr size_t WS_W = 8 * MiB;
constexpr size_t WS_HN = 112 * MiB;
constexpr size_t WS_PROJ = 176 * MiB;
constexpr size_t WS_R2 = 368 * MiB;
constexpr size_t WS_END = 496 * MiB;
constexpr size_t R2_KVMLA = 48 * MiB, R2_OB = 64 * MiB, R2_HALO = 64 * MiB, R2_PART = 76 * MiB, R2_VAL = 88 * MiB;
constexpr size_t OW_EIN = 0;
constexpr size_t OW_EUQ = OW_EIN + 2ull * EIN_NP * 1024;
constexpr size_t OW_EUKV = OW_EUQ + 2ull * 768 * 384;
constexpr size_t OW_EOUT = OW_EUKV + 2ull * 1024 * 256;
constexpr size_t OW_OIN = OW_EOUT + 2ull * 1024 * 1024;
constexpr size_t OW_OOUT = OW_OIN + 2ull * OIN_N * 1024;
constexpr size_t OW_UP = OW_OOUT + 2ull * 1024 * 1024;
constexpr size_t OW_DN = OW_UP + 4ull * 5632 * 1024;
constexpr size_t OW_END = OW_DN + 4ull * 1024 * D_FF;
static_assert(WS_W + OW_END * 2 <= WS_HN, "weights fit");

constexpr int LDS_BYTES = 135168;
constexpr int NTHREADS = 512, NWAVES = 8;

__device__ __forceinline__ unsigned cvt_pk_bf16(float lo, float hi) { unsigned r; asm volatile("v_cvt_pk_bf16_f32 %0, %1, %2" : "=v"(r) : "v"(lo), "v"(hi)); return r; }
__device__ __forceinline__ float bf_lo(unsigned w) { return __uint_as_float(w << 16); }
__device__ __forceinline__ float bf_hi(unsigned w) { return __uint_as_float(w & 0xffff0000u); }
__device__ __forceinline__ float bf2f(bf16_t v) { return __uint_as_float(((unsigned)v) << 16); }
__device__ __forceinline__ float shflx(float v, int m, int lane) { return __int_as_float(__builtin_amdgcn_ds_bpermute((lane ^ m) << 2, __float_as_int(v))); }
__device__ __forceinline__ float wave_sum(float v, int lane) {
#pragma unroll
    for (int o = 1; o < 64; o <<= 1) v += shflx(v, o, lane);
    return v;
}
__device__ __forceinline__ float gelu_tanh(float x) {
    const float u = 0.7978845608028654f * (x + 0.044715f * x * x * x);
    const float e = __builtin_amdgcn_exp2f(-2.0f * LOG2E * u);
    return x * __builtin_amdgcn_rcpf(1.0f + e);
}

namespace pg8 {
constexpr int BM = 256, BK = 64, HALF = 128, HTB = HALF * BK * 2, STAGE_BYTES = 8 * HTB, NXCD = 8, WGM = 8;
__host__ __device__ __forceinline__ int lds_byte(int r, int c) { const int st = (r >> 4) * 2 + (c >> 5), rr = r & 15, cc = c & 31, ob = rr * 64 + cc * 2; return st * 1024 + (ob ^ (((ob >> 9) & 1) << 5)); }
__host__ __device__ __forceinline__ void stage_rc(int b, int& R, int& C) { const int st = b / 1024, sb = b % 1024, swz = sb ^ (((sb >> 9) & 1) << 5); R = (st >> 1) * 16 + swz / 64; C = (st & 1) * 32 + (swz % 64) / 2; }
__host__ __device__ __forceinline__ int perm32(int rho) { const int n = rho >> 4, i = rho & 15; return 8 * (i >> 2) + 4 * n + (i & 3); }

struct Unit { int pm, pn; };
struct Gemm { const bf16_t* A; const bf16_t* Bt; int M, N, K, lda, ldb; };

struct StaticOrder {
    int nM, nN, nwg, G, c;
    __host__ __device__ void init(int M, int N, int G_, int c_) { nM = M / BM; nN = N / BM; nwg = nM * nN; G = G_; c = c_; }
    __host__ __device__ bool next(int i, Unit& u) const {
        const long L = (long)i * G + c; if (L >= nwg) return false;
        int wgid = (int)L; { const int q = nwg / NXCD, r = nwg % NXCD, xcd = wgid % NXCD, off = wgid / NXCD; wgid = (xcd < r ? xcd * (q + 1) : r * (q + 1) + (xcd - r) * q) + off; }
        const int nig = WGM * nN, gid = wgid / nig, fm = gid * WGM, gsz = (nM - fm) < WGM ? (nM - fm) : WGM;
        u.pm = fm + ((wgid % nig) % gsz); u.pn = (wgid % nig) / gsz; return true;
    }
};

template <class Epi, class Sched, bool ALIGN_EPI>
__device__ __forceinline__ void gemm_phase(LAS unsigned char* lds, const Gemm g, const Sched& S, const Epi& E, const int tid) {
    const int wid = __builtin_amdgcn_readfirstlane(tid >> 6), lane = tid & 63, wr = wid >> 2, wc = wid & 3, fr = lane & 15, fq = lane >> 4;
    const int K = g.K, nt = K / BK;
    unsigned voffA[2], voffB[2];
#pragma unroll
    for (int i = 0; i < 2; ++i) { int R, C; stage_rc(tid * 16 + i * 8192, R, C); const int Rb = (R & ~31) + perm32(R & 31);
        voffA[i] = (unsigned)(R * g.lda + C) * 2u; voffB[i] = (unsigned)(Rb * g.ldb + C) * 2u; }
    const size_t kstep = (size_t)(BK * 2);
    const size_t hstepA = (size_t)HALF * g.lda * 2, hstepB = (size_t)HALF * g.ldb * 2;
    const size_t tstepA = 2 * hstepA, tstepB = 2 * hstepB;
    const unsigned ldsw = (unsigned)wid * 1024u;
    const int aoff = lds_byte(wr * 64 + fr, fq * 8), boff = lds_byte(wc * 32 + fr, fq * 8);
#define PG8_SA(b, h) (((b) * 2 + (h)) * HTB)
#define PG8_SB(b, h) ((4 + (b) * 2 + (h)) * HTB)
#define PG8_STAGE(bufoff, gbase, voff) do { _Pragma("unroll") for (int _i = 0; _i < 2; ++_i) \
        __builtin_amdgcn_global_load_lds((const unsigned*)((const char*)(gbase) + (voff)[_i]), (LAS unsigned*)(lds + (bufoff) + ldsw + _i * 8192), 16, 0, 0); } while (0)
#define PG8_LDA(dst, b, h) do { _Pragma("unroll") for (int m = 0; m < 4; ++m) _Pragma("unroll") for (int k = 0; k < 2; ++k) dst[m][k] = *(const LAS bf16x8*)(lds + PG8_SA(b, h) + aoff + m * 2048 + k * 1024); } while (0)
#define PG8_LDB(dst, b, h) do { _Pragma("unroll") for (int n = 0; n < 2; ++n) _Pragma("unroll") for (int k = 0; k < 2; ++k) dst[n][k] = *(const LAS bf16x8*)(lds + PG8_SB(b, h) + boff + n * 2048 + k * 1024); } while (0)
#define PG8_MMA(ai, bj, At, Bt) do { __builtin_amdgcn_s_setprio(1); _Pragma("unroll") for (int m = 0; m < 4; ++m) _Pragma("unroll") for (int n = 0; n < 2; ++n) _Pragma("unroll") for (int k = 0; k < 2; ++k) \
        acc[ai][bj][m][n] = __builtin_amdgcn_mfma_f32_16x16x32_bf16(Bt[n][k], At[m][k], acc[ai][bj][m][n], 0, 0, 0); __builtin_amdgcn_s_setprio(0); } while (0)
#define PG8_WAIT_V(n) asm volatile("s_waitcnt vmcnt(" #n ")" ::: "memory")
#define PG8_WAIT_L(n) asm volatile("s_waitcnt lgkmcnt(" #n ")" ::: "memory")
#define PG8_BAR __builtin_amdgcn_s_barrier()
#define PG8_SCHED __builtin_amdgcn_sched_barrier(0)
    Unit cur, nxt; int ui = 0;
    if (!S.next(0, cur)) return;
    f32x4 acc[2][2][4][2];
#pragma unroll
    for (int a = 0; a < 2; ++a)
#pragma unroll
        for (int b = 0; b < 2; ++b)
#pragma unroll
            for (int m = 0; m < 4; ++m)
#pragma unroll
                for (int n = 0; n < 2; ++n) acc[a][b][m][n] = (f32x4){0.f, 0.f, 0.f, 0.f};
    bf16x8 At[4][2], B0[2][2], B1[2][2];
    const char* cA = (const char*)g.A + (size_t)cur.pm * tstepA; const char* cB = (const char*)g.Bt + (size_t)cur.pn * tstepB;
    PG8_STAGE(PG8_SB(0, 0), cB, voffB); PG8_STAGE(PG8_SB(0, 1), cB + hstepB, voffB); PG8_STAGE(PG8_SA(0, 0), cA, voffA); PG8_STAGE(PG8_SA(0, 1), cA + hstepA, voffA);
    if (wr == 1) PG8_BAR;
    PG8_WAIT_V(2); PG8_BAR;
    PG8_STAGE(PG8_SB(1, 0), cB + kstep, voffB); PG8_STAGE(PG8_SA(1, 0), cA + kstep, voffA); PG8_STAGE(PG8_SB(1, 1), cB + hstepB + kstep, voffB);
    PG8_WAIT_V(6); PG8_BAR;
    for (;;) {
        const bool has_next = S.next(ui + 1, nxt);
        const char* nA = has_next ? (const char*)g.A + (size_t)nxt.pm * tstepA : cA; const char* nB = has_next ? (const char*)g.Bt + (size_t)nxt.pn * tstepB : cB;
        for (int t = 0; t < nt; t += 2) {
            const bool last = (t == nt - 2);
            const char* a1 = cA + (size_t)(t + 1) * kstep;
            const char* a2 = last ? nA : cA + (size_t)(t + 2) * kstep; const char* b2 = last ? nB : cB + (size_t)(t + 2) * kstep;
            const char* a3 = a2 + kstep; const char* b3 = b2 + kstep;
            PG8_LDB(B0, 0, 0); PG8_LDB(B1, 0, 1); PG8_SCHED; PG8_LDA(At, 0, 0); PG8_STAGE(PG8_SA(1, 1), a1 + hstepA, voffA);
            PG8_WAIT_V(8); PG8_WAIT_L(0); PG8_BAR; PG8_MMA(0, 0, At, B0); PG8_MMA(0, 1, At, B1); PG8_BAR; PG8_SCHED;
            PG8_LDA(At, 0, 1); PG8_STAGE(PG8_SB(0, 0), b2, voffB); PG8_STAGE(PG8_SB(0, 1), b2 + hstepB, voffB); PG8_STAGE(PG8_SA(0, 0), a2, voffA);
            PG8_WAIT_V(8); PG8_WAIT_L(0); PG8_BAR; PG8_MMA(1, 0, At, B0); PG8_MMA(1, 1, At, B1); PG8_BAR; PG8_SCHED;
            PG8_LDB(B0, 1, 0); PG8_LDB(B1, 1, 1); PG8_SCHED; PG8_LDA(At, 1, 0); PG8_STAGE(PG8_SA(0, 1), a2 + hstepA, voffA);
            PG8_WAIT_V(8); PG8_WAIT_L(0); PG8_BAR; PG8_MMA(0, 0, At, B0); PG8_MMA(0, 1, At, B1); PG8_BAR; PG8_SCHED;
            PG8_LDA(At, 1, 1); PG8_STAGE(PG8_SB(1, 0), b3, voffB); PG8_STAGE(PG8_SB(1, 1), b3 + hstepB, voffB); PG8_STAGE(PG8_SA(1, 0), a3, voffA);
            PG8_WAIT_V(8); PG8_WAIT_L(0); PG8_BAR; PG8_MMA(1, 0, At, B0); PG8_MMA(1, 1, At, B1); PG8_BAR; PG8_SCHED;
        }
        if constexpr (ALIGN_EPI) { if (wr == 0) PG8_BAR; }
        E(acc, cur, wr, wc, fr, fq);
        if (!has_next) break;
#pragma unroll
        for (int a = 0; a < 2; ++a)
#pragma unroll
            for (int b = 0; b < 2; ++b)
#pragma unroll
                for (int m = 0; m < 4; ++m)
#pragma unroll
                    for (int n = 0; n < 2; ++n) acc[a][b][m][n] = (f32x4){0.f, 0.f, 0.f, 0.f};
        cur = nxt; cA = nA; cB = nB; ++ui;
        if constexpr (ALIGN_EPI) { if (wr == 1) PG8_BAR; }
    }
    PG8_WAIT_V(0);
    if constexpr (!ALIGN_EPI) { if (wr == 0) PG8_BAR; }
    PG8_BAR;
#undef PG8_SA
#undef PG8_SB
#undef PG8_STAGE
#undef PG8_LDA
#undef PG8_LDB
#undef PG8_MMA
#undef PG8_WAIT_V
#undef PG8_WAIT_L
#undef PG8_BAR
#undef PG8_SCHED
}
}

struct EpiStore {
    bf16_t* O; int ldc; int scale_cols; float s0; const float* rowscale; float rs_mul; const float* ropec; const float* ropes;
    __device__ __forceinline__ void operator()(const f32x4 (&acc)[2][2][4][2], const pg8::Unit& u, int wr, int wc, int fr, int fq) const {
        const int row0 = u.pm * 256 + wr * 64 + fr;
#pragma unroll
        for (int bj = 0; bj < 2; ++bj) {
            const int colg = u.pn * 256 + bj * 128 + wc * 32, col0 = colg + 8 * fq;
            const float sc = (colg < scale_cols) ? s0 : 1.0f;
            const bool rope = (ropec != nullptr) && (((colg >> 5) % 3) == 2);
#pragma unroll
            for (int ai = 0; ai < 2; ++ai)
#pragma unroll
                for (int m = 0; m < 4; ++m) {
                    const int row = row0 + ai * 128 + m * 16;
                    float f = sc; if (rowscale) f *= rowscale[row] * rs_mul;
                    f32x4 v0 = acc[ai][bj][m][0] * f, v1 = acc[ai][bj][m][1] * f;
                    if (rope) {
                        const int pos = row & (SEQ - 1), i0 = (8 * fq) & 15;
                        const f32x4 c0 = *(const f32x4*)(ropec + pos * 16 + i0), c1 = *(const f32x4*)(ropec + pos * 16 + i0 + 4);
                        const f32x4 s0v = *(const f32x4*)(ropes + pos * 16 + i0), s1v = *(const f32x4*)(ropes + pos * 16 + i0 + 4);
                        f32x4 p0, p1;
#pragma unroll
                        for (int e = 0; e < 4; ++e) { p0[e] = shflx(v0[e], 32, fq * 16 + fr); p1[e] = shflx(v1[e], 32, fq * 16 + fr); }
                        if (fq < 2) { v0 = v0 * c0 - p0 * s0v; v1 = v1 * c1 - p1 * s1v; }
                        else { v0 = p0 * s0v + v0 * c0; v1 = p1 * s1v + v1 * c1; }
                    }
                    u32x4 w; w.x = cvt_pk_bf16(v0[0], v0[1]); w.y = cvt_pk_bf16(v0[2], v0[3]); w.z = cvt_pk_bf16(v1[0], v1[1]); w.w = cvt_pk_bf16(v1[2], v1[3]);
                    *(u32x4*)(O + (size_t)row * ldc + col0) = w;
                }
        }
    }
};

__device__ __forceinline__ float dpp_ror1(float v) { return __int_as_float(__builtin_amdgcn_update_dpp(0, __float_as_int(v), 0x121, 0xf, 0xf, false)); }
__device__ __forceinline__ float dpp_ror2(float v) { return __int_as_float(__builtin_amdgcn_update_dpp(0, __float_as_int(v), 0x122, 0xf, 0xf, false)); }

struct EpiConv {
    bf16_t* act; const float* cw; const float* cb; float* halo; float* part; float* val01;
    __device__ __forceinline__ void operator()(const f32x4 (&acc)[2][2][4][2], const pg8::Unit& u, int wr, int wc, int fr, int fq) const {
        const int colb = u.pn * 128 + wc * 32 + 8 * fq;
        f32x4 w0[2], w1[2], w2[2], bb[2];
#pragma unroll
        for (int n = 0; n < 2; ++n) { const int col = colb + 4 * n;
            w0[n] = *(const f32x4*)(cw + col); w1[n] = *(const f32x4*)(cw + D_FF + col); w2[n] = *(const f32x4*)(cw + 2 * D_FF + col); bb[n] = *(const f32x4*)(cb + col); }
#pragma unroll
        for (int ai = 0; ai < 2; ++ai) {
            const int chunk = u.pm * 4 + ai * 2 + wr;
            f32x4 gprev[2]; gprev[0] = (f32x4){0.f, 0.f, 0.f, 0.f}; gprev[1] = gprev[0];
#pragma unroll
            for (int m = 0; m < 4; ++m) {
                const int row = u.pm * 256 + ai * 128 + wr * 64 + m * 16 + fr;
                u32x4 wq;
#pragma unroll
                for (int n = 0; n < 2; ++n) {
                    const int col = colb + 4 * n;
                    const f32x4 g = acc[ai][0][m][n], v = acc[ai][1][m][n];
                    f32x4 cv, o;
#pragma unroll
                    for (int e = 0; e < 4; ++e) {
                        const float h1 = (fr == 15) ? gprev[n][e] : g[e], h2 = (fr >= 14) ? gprev[n][e] : g[e];
                        const float p1 = dpp_ror1(h1), p2 = dpp_ror2(h2);
                        cv[e] = bb[n][e] + w2[n][e] * g[e] + w1[n][e] * p1 + w0[n][e] * p2;
                        const float x = cv[e], t = x * x * (-0.10294324f) + (-2.302208198f);
                        const float ex = __builtin_amdgcn_exp2f(x * t);
                        o[e] = (x * v[e]) * __builtin_amdgcn_rcpf(1.0f + ex);
                    }
                    if (m == 0 && fr < 2) { *(f32x4*)(part + (size_t)(chunk * 2 + fr) * D_FF + col) = cv; *(f32x4*)(val01 + (size_t)(chunk * 2 + fr) * D_FF + col) = v; }
                    if (m == 3 && fr >= 14) { *(f32x4*)(halo + (size_t)(chunk * 2 + fr - 14) * D_FF + col) = g; }
                    if (n == 0) { wq.x = cvt_pk_bf16(o[0], o[1]); wq.y = cvt_pk_bf16(o[2], o[3]); } else { wq.z = cvt_pk_bf16(o[0], o[1]); wq.w = cvt_pk_bf16(o[2], o[3]); }
                    gprev[n] = g;
                }
                *(u32x4*)(act + (size_t)row * D_FF + colb) = wq;
            }
        }
    }
};

struct AttnP {
    const bf16_t* Q; int ldq;
    const bf16_t* K1; int ldk1;
    const bf16_t* K2;
    const bf16_t* V; int ldv;
    bf16_t* O; int ldo;
    const float* bias;
    float sl2;
    const bf16_t* Oprev;
    const float* subln; float lam, osc;
};


__device__ __forceinline__ float max3f(float a, float b, float c) { float r; asm("v_max3_f32 %0, %1, %2, %3" : "=v"(r) : "v"(a), "v"(b), "v"(c)); return r; }
__device__ __forceinline__ float fadd_s(float a, float b) { float r; asm("v_add_f32_e32 %0, %1, %2" : "=v"(r) : "v"(a), "v"(b)); return r; }
__device__ __forceinline__ float fsub_s(float a, float b) { float r; asm("v_sub_f32_e32 %0, %1, %2" : "=v"(r) : "v"(a), "v"(b)); return r; }
__device__ __forceinline__ int crow(int r, int hi) { return (r & 3) + 8 * (r >> 2) + 4 * hi; }

template <int DQK, int DV, int MODE>
__device__ __forceinline__ void attn_unit(LAS unsigned char* lds, const AttnP& P, size_t rowbase, int qb, const int tid, const int pm) {
    constexpr int KST = DQK * 2 + 16, VST = (DV == 64) ? 192 : 320;
    constexpr int KBYTES = 64 * KST, VBYTES = 64 * VST, BUF = KBYTES + VBYTES + 256;
    constexpr int NKS = DQK / 16, NDB = DV / 32;
    const int lane = tid & 63, wid = __builtin_amdgcn_readfirstlane(tid >> 6), r32 = lane & 31, hi = lane >> 5;
    const int q0 = qb * 256, NT = 4 * qb + 4, ktlast = 4 * qb + (wid >> 1);
    const int qpos = q0 + wid * 32 + r32;
    bf16x8 qf[NKS];
    {
        const bf16_t* qrow = P.Q + (rowbase + qpos) * (size_t)P.ldq + hi * 8;
#pragma unroll
        for (int ks = 0; ks < NKS; ++ks) qf[ks] = *(const bf16x8*)(qrow + ks * 16);
    }
    float cq2 = 0.f;
    if (MODE == 0) cq2 = P.bias[qpos];
    float sdiag = 0.f;
    {
        const bf16_t* kd = P.K1 + (rowbase + qpos) * (size_t)P.ldk1 + hi * 8;
#pragma unroll
        for (int ks = 0; ks < NKS; ++ks) {
            const u32x4 kv_ = (MODE == 1 && ks >= 4) ? *(const u32x4*)(P.K2 + (rowbase + qpos) * 32 + (ks - 4) * 16 + hi * 8) : *(const u32x4*)(kd + ks * 16);
            const u32x4 qv_ = __builtin_bit_cast(u32x4, qf[ks]);
            sdiag += bf_lo(qv_.x) * bf_lo(kv_.x) + bf_hi(qv_.x) * bf_hi(kv_.x) + bf_lo(qv_.y) * bf_lo(kv_.y) + bf_hi(qv_.y) * bf_hi(kv_.y)
                   + bf_lo(qv_.z) * bf_lo(kv_.z) + bf_hi(qv_.z) * bf_hi(kv_.z) + bf_lo(qv_.w) * bf_lo(kv_.w) + bf_hi(qv_.w) * bf_hi(kv_.w);
        }
        auto rr_ = __builtin_amdgcn_permlane32_swap(__float_as_uint(sdiag), __float_as_uint(sdiag), false, false);
        sdiag = __uint_as_float(rr_[0]) + __uint_as_float(rr_[1]);
    }
    u32x4 kA0, kA1, vA0, vA1, kB0, kB1, vB0, vB1; float bA = 0.f, bB = 0.f;
    kA1 = (u32x4){0, 0, 0, 0}; vA1 = kA1; kB1 = kA1; vB1 = kA1;
    const int krow = tid >> 3, kch = tid & 7, k2row = tid >> 2, k2ch = tid & 3;
    const int vrow = (DV == 64) ? (tid >> 3) : (tid >> 4), vch = (DV == 64) ? (tid & 7) : (tid & 15);
    const unsigned koff = (unsigned)(krow * P.ldk1 + kch * 8), k2off = (unsigned)(k2row * 32 + k2ch * 8), voff0 = (unsigned)(vrow * P.ldv + vch * 8), voff1 = voff0 + 32u * (unsigned)P.ldv;
#define ATT_LOAD(X, kt) do { const size_t tr0 = rowbase + (size_t)(kt) * 64; \
        const bf16_t* kb_u = P.K1 + tr0 * P.ldk1; const bf16_t* vb_u = P.V + tr0 * P.ldv; \
        k##X##0 = *(const u32x4*)(kb_u + koff); \
        if (MODE == 1) { const bf16_t* k2_u = P.K2 + tr0 * 32; if (tid < 256) k##X##1 = *(const u32x4*)(k2_u + k2off); } \
        v##X##0 = *(const u32x4*)(vb_u + voff0); \
        if (DV == 128) v##X##1 = *(const u32x4*)(vb_u + voff1); \
        if (MODE == 0) { const float* b_u = P.bias + (kt) * 64; if (tid < 64) b##X = b_u[(unsigned)tid]; } } while (0)
#define ATT_STORE(X, buf) do { LAS unsigned char* bb_ = lds + (buf) * BUF; \
        *(LAS u32x4*)(bb_ + krow * KST + kch * 16) = k##X##0; \
        if (MODE == 1) { if (tid < 256) *(LAS u32x4*)(bb_ + k2row * KST + (8 + k2ch) * 16) = k##X##1; } \
        *(LAS u32x4*)(bb_ + KBYTES + vrow * VST + vch * 16) = v##X##0; \
        if (DV == 128) *(LAS u32x4*)(bb_ + KBYTES + (vrow + 32) * VST + vch * 16) = v##X##1; \
        if (MODE == 0) { if (tid < 64) *(LAS float*)(bb_ + KBYTES + VBYTES + tid * 4) = b##X; } } while (0)

    f32x16 o[NDB];
#pragma unroll
    for (int db = 0; db < NDB; ++db)
#pragma unroll
        for (int r = 0; r < 16; ++r) o[db][r] = 0.f;
    float mref = sdiag, lrun = 0.f;

    bf16x8 kf[2 * NKS];
#define ATT_READV(dst, db) do { _Pragma("unroll") for (int s_ = 0; s_ < 4; ++s_) { \
        const s16x4 t1 = __builtin_amdgcn_ds_read_tr16_b64_v4i16((LAS s16x4*)(vlane + (16 * s_) * VST + (db) * 64)); \
        const s16x4 t2 = __builtin_amdgcn_ds_read_tr16_b64_v4i16((LAS s16x4*)(vlane + (16 * s_ + 8) * VST + (db) * 64)); \
        dst[s_] = (bf16x8){t1[0], t1[1], t1[2], t1[3], t2[0], t2[1], t2[2], t2[3]}; } } while (0)
#define ATT_COMPUTE(kt, cb, RDK, PFK) do { \
            LAS unsigned char* kb = lds + (cb) * BUF; \
            LAS unsigned char* vb = kb + KBYTES; \
            bf16x8 kfl_[2 * NKS]; bf16x8 (&kfr)[2 * NKS] = *((MODE == 0) ? &kf : &kfl_); \
            f32x16 s0, s1; \
            if (MODE == 0) { \
                LAS unsigned char* bp = vb + VBYTES; const float cqm = cq2 - mref; \
                _Pragma("unroll") for (int a = 0; a < 4; ++a) { \
                    const f32x4 c0 = *(LAS f32x4*)(bp + (8 * a + 4 * hi) * 4), c1 = *(LAS f32x4*)(bp + (32 + 8 * a + 4 * hi) * 4); \
                    _Pragma("unroll") for (int e = 0; e < 4; ++e) { s0[4 * a + e] = fsub_s(cqm, c0[e]); s1[4 * a + e] = fsub_s(cqm, c1[e]); } } \
            } else if (MODE == 2) { \
                const float c0 = P.sl2 * (float)((kt) * 64 + 4 * hi - qpos) - mref; \
                const float c32 = 32.0f * P.sl2; _Pragma("unroll") for (int r = 0; r < 16; ++r) { s0[r] = fadd_s(c0, P.sl2 * (float)((r & 3) + 8 * (r >> 2))); s1[r] = fadd_s(s0[r], c32); } \
            } else { \
                _Pragma("unroll") for (int r = 0; r < 16; ++r) { s0[r] = -mref; s1[r] = -mref; } \
            } \
            { if (RDK) { _Pragma("unroll") for (int ks = 0; ks < NKS; ++ks) { \
                kfr[2 * ks] = *(LAS bf16x8*)(kb + r32 * KST + ks * 32 + hi * 16); \
                kfr[2 * ks + 1] = *(LAS bf16x8*)(kb + (r32 + 32) * KST + ks * 32 + hi * 16); } } \
              if (DV == 64) __builtin_amdgcn_sched_barrier(0); \
              __builtin_amdgcn_s_setprio(1); \
              _Pragma("unroll") for (int ks = 0; ks < NKS; ++ks) { \
                s0 = __builtin_amdgcn_mfma_f32_32x32x16_bf16(kfr[2 * ks], qf[ks], s0, 0, 0, 0); \
                s1 = __builtin_amdgcn_mfma_f32_32x32x16_bf16(kfr[2 * ks + 1], qf[ks], s1, 0, 0, 0); } \
              __builtin_amdgcn_s_setprio(0); \
              if (PFK) { LAS unsigned char* kn_ = kb + BUF; _Pragma("unroll") for (int ks = 0; ks < NKS; ++ks) { \
                kfr[2 * ks] = *(LAS bf16x8*)(kn_ + r32 * KST + ks * 32 + hi * 16); \
                kfr[2 * ks + 1] = *(LAS bf16x8*)(kn_ + (r32 + 32) * KST + ks * 32 + hi * 16); } } } \
            LAS unsigned char* vlane = vb + (4 * hi + ((lane & 15) >> 2)) * VST + (16 * ((lane >> 4) & 1) + 4 * (lane & 3)) * 2; \
            bf16x8 vf[2][4]; \
            if (DV == 64) { ATT_READV(vf[0], 0); } \
            __builtin_amdgcn_sched_barrier(0); \
            if ((kt) == ktlast) { \
                const int kbase = (kt) * 64 + 4 * hi; \
                _Pragma("unroll") for (int r = 0; r < 16; ++r) { const int key = kbase + (r & 3) + 8 * (r >> 2); if (key > qpos) s0[r] = NEGBIG; if (key + 32 > qpos) s1[r] = NEGBIG; } } \
            float mx = max3f(s0[0], s1[0], s0[1]), mx2 = max3f(s1[1], s0[2], s1[2]); \
            _Pragma("unroll") for (int r = 3; r < 15; r += 2) { mx = max3f(mx, s0[r], s1[r]); mx2 = max3f(mx2, s0[r + 1], s1[r + 1]); } \
            mx = max3f(mx, s0[15], s1[15]); mx = max3f(mx, mx2, mx2); \
            if (__any(mx > 64.0f)) { \
                { auto rr_ = __builtin_amdgcn_permlane32_swap(__float_as_uint(mx), __float_as_uint(mx), false, false); mx = fmaxf(__uint_as_float(rr_[0]), __uint_as_float(rr_[1])); } \
                const float dl = fmaxf(mx, 0.f); \
                const float alpha = __builtin_amdgcn_exp2f(-dl); \
                mref += dl; lrun *= alpha; \
                _Pragma("unroll") for (int r = 0; r < 16; ++r) { s0[r] -= dl; s1[r] -= dl; } \
                _Pragma("unroll") for (int db = 0; db < NDB; ++db) _Pragma("unroll") for (int r = 0; r < 16; ++r) o[db][r] *= alpha; } \
            float ls = 0.f, ls2 = 0.f; \
            _Pragma("unroll") for (int r = 0; r < 16; ++r) { s0[r] = __builtin_amdgcn_exp2f(s0[r]); s1[r] = __builtin_amdgcn_exp2f(s1[r]); ls = fadd_s(ls, s0[r]); ls2 = fadd_s(ls2, s1[r]); } \
            lrun += fadd_s(ls, ls2); \
            u32x4 pw[4]; \
            pw[0] = (u32x4){cvt_pk_bf16(s0[0], s0[1]), cvt_pk_bf16(s0[2], s0[3]), cvt_pk_bf16(s0[4], s0[5]), cvt_pk_bf16(s0[6], s0[7])}; \
            pw[1] = (u32x4){cvt_pk_bf16(s0[8], s0[9]), cvt_pk_bf16(s0[10], s0[11]), cvt_pk_bf16(s0[12], s0[13]), cvt_pk_bf16(s0[14], s0[15])}; \
            pw[2] = (u32x4){cvt_pk_bf16(s1[0], s1[1]), cvt_pk_bf16(s1[2], s1[3]), cvt_pk_bf16(s1[4], s1[5]), cvt_pk_bf16(s1[6], s1[7])}; \
            pw[3] = (u32x4){cvt_pk_bf16(s1[8], s1[9]), cvt_pk_bf16(s1[10], s1[11]), cvt_pk_bf16(s1[12], s1[13]), cvt_pk_bf16(s1[14], s1[15])}; \
            if (DV != 64) { ATT_READV(vf[0], 0); } \
            _Pragma("unroll") for (int db = 0; db < NDB; ++db) { \
                if (db + 1 < NDB) ATT_READV(vf[(db + 1) & 1], db + 1); \
                __builtin_amdgcn_sched_barrier(0); \
                __builtin_amdgcn_s_setprio(1); \
                _Pragma("unroll") for (int s = 0; s < 4; ++s) \
                    o[db] = __builtin_amdgcn_mfma_f32_32x32x16_bf16(vf[db & 1][s], __builtin_bit_cast(bf16x8, pw[s]), o[db], 0, 0, 0); \
                __builtin_amdgcn_s_setprio(0); \
                __builtin_amdgcn_sched_barrier(0); } \
        } while (0)

#define ATT_BAR() do { asm volatile("s_waitcnt lgkmcnt(0)" ::: "memory"); __builtin_amdgcn_s_barrier(); asm volatile("" ::: "memory"); } while (0)
    ATT_LOAD(A, 0); ATT_LOAD(B, 1);
    ATT_STORE(A, 0); ATT_STORE(B, 1);
    ATT_LOAD(A, 2); ATT_LOAD(B, 3);
    ATT_BAR();
    for (int kt = 0; kt < NT; kt += 2) {
        const int sb = (kt & 2);
        const bool two_ = (kt + 1 <= ktlast);
        if (kt <= ktlast && pm != 1) ATT_COMPUTE(kt, sb, true, (KPF2 && MODE == 0 && two_));
        if (two_ && pm != 1) ATT_COMPUTE(kt + 1, sb + 1, !(KPF2 && MODE == 0), false);
        if (kt + 2 < NT && pm < 2) { ATT_STORE(A, sb ^ 2); ATT_STORE(B, (sb ^ 2) + 1); }
        if (pm != 3) ATT_BAR();
        if (kt + 4 < NT && pm < 2) { ATT_LOAD(A, kt + 4); ATT_LOAD(B, kt + 5); }
    }
    ATT_BAR();
    float ltot; { auto rr_ = __builtin_amdgcn_permlane32_swap(__float_as_uint(lrun), __float_as_uint(lrun), false, false); ltot = __uint_as_float(rr_[0]) + __uint_as_float(rr_[1]); }
    const float inv = 1.0f / ltot;
    int qpe_ = qpos; asm volatile("" : "+v"(qpe_));
    bf16_t* orow = P.O + (rowbase + qpe_) * (size_t)P.ldo + 8 * hi;
    if (MODE == 2 && P.Oprev != nullptr) {
        const bf16_t* prow = P.Oprev + (rowbase + qpe_) * (size_t)P.ldo + 8 * hi;
        f32x4 cv[NDB][2][2]; float ss = 0.f;
#pragma unroll
        for (int db = 0; db < NDB; ++db)
#pragma unroll
            for (int a = 0; a < 4; a += 2) {
                const unsigned x0 = cvt_pk_bf16(o[db][4 * a] * inv, o[db][4 * a + 1] * inv), x1 = cvt_pk_bf16(o[db][4 * a + 2] * inv, o[db][4 * a + 3] * inv);
                const unsigned y0 = cvt_pk_bf16(o[db][4 * a + 4] * inv, o[db][4 * a + 5] * inv), y1 = cvt_pk_bf16(o[db][4 * a + 6] * inv, o[db][4 * a + 7] * inv);
                const auto s0_ = __builtin_amdgcn_permlane32_swap(x0, y0, false, false);
                const auto s1_ = __builtin_amdgcn_permlane32_swap(x1, y1, false, false);
                const u32x4 w1 = *(const u32x4*)(prow + db * 32 + a * 8);
                const f32x4 d0 = (f32x4){bf_lo(w1.x) - P.lam * bf_lo(s0_[0]), bf_hi(w1.x) - P.lam * bf_hi(s0_[0]), bf_lo(w1.y) - P.lam * bf_lo(s1_[0]), bf_hi(w1.y) - P.lam * bf_hi(s1_[0])};
                const f32x4 d1 = (f32x4){bf_lo(w1.z) - P.lam * bf_lo(s0_[1]), bf_hi(w1.z) - P.lam * bf_hi(s0_[1]), bf_lo(w1.w) - P.lam * bf_lo(s1_[1]), bf_hi(w1.w) - P.lam * bf_hi(s1_[1])};
                cv[db][a >> 1][0] = d0; cv[db][a >> 1][1] = d1;
                ss += (d0[0] * d0[0] + d0[1] * d0[1]) + (d0[2] * d0[2] + d0[3] * d0[3]) + (d1[0] * d1[0] + d1[1] * d1[1]) + (d1[2] * d1[2] + d1[3] * d1[3]);
            }
        { auto rr_ = __builtin_amdgcn_permlane32_swap(__float_as_uint(ss), __float_as_uint(ss), false, false); ss = __uint_as_float(rr_[0]) + __uint_as_float(rr_[1]); }
        const float rs = rsqrtf(ss * (1.0f / 128.0f) + RMS_EPS) * P.osc;
        const float* sgp = P.subln + 8 * hi;
#pragma unroll
        for (int db = 0; db < NDB; ++db)
#pragma unroll
            for (int a = 0; a < 4; a += 2) {
                const f32x4 g0 = *(const f32x4*)(sgp + db * 32 + a * 8), g1 = *(const f32x4*)(sgp + db * 32 + a * 8 + 4);
                const f32x4 e0 = cv[db][a >> 1][0] * rs * g0, e1 = cv[db][a >> 1][1] * rs * g1;
                u32x4 w; w.x = cvt_pk_bf16(e0[0], e0[1]); w.y = cvt_pk_bf16(e0[2], e0[3]); w.z = cvt_pk_bf16(e1[0], e1[1]); w.w = cvt_pk_bf16(e1[2], e1[3]);
                *(u32x4*)(orow + db * 32 + a * 8) = w;
            }
    } else {
#pragma unroll
    for (int db = 0; db < NDB; ++db)
#pragma unroll
        for (int a = 0; a < 4; a += 2) {
            const unsigned x0 = cvt_pk_bf16(o[db][4 * a] * inv, o[db][4 * a + 1] * inv), x1 = cvt_pk_bf16(o[db][4 * a + 2] * inv, o[db][4 * a + 3] * inv);
            const unsigned y0 = cvt_pk_bf16(o[db][4 * a + 4] * inv, o[db][4 * a + 5] * inv), y1 = cvt_pk_bf16(o[db][4 * a + 6] * inv, o[db][4 * a + 7] * inv);
            const auto s0_ = __builtin_amdgcn_permlane32_swap(x0, y0, false, false);
            const auto s1_ = __builtin_amdgcn_permlane32_swap(x1, y1, false, false);
            u32x4 w; w.x = s0_[0]; w.y = s1_[0]; w.z = s0_[1]; w.w = s1_[1];
            *(u32x4*)(orow + db * 32 + a * 8) = w;
        }
    }
#undef ATT_COMPUTE
#undef ATT_READV
#undef ATT_BAR
#undef ATT_LOAD
#undef ATT_STORE
}


#define XB_TMO      128
#define XB_XCNT(j)  (256  + 64 * (j))
#define XB_XSUB(j)  (1280 + 64 * (j))
#define XB_XGEN(j)  (2304 + 64 * (j))
#define XB_TOP      3328
#define XB_TOPGEN   3392
#define XCD_BAR_WORDS 3456
#define XB_SPIN_CAP (1u << 18)

__device__ __forceinline__ unsigned xb_ld(unsigned* p)              { return __hip_atomic_load(p, __ATOMIC_RELAXED, __HIP_MEMORY_SCOPE_AGENT); }
__device__ __forceinline__ unsigned xb_add(unsigned* p, unsigned v) { return __hip_atomic_fetch_add(p, v, __ATOMIC_RELAXED, __HIP_MEMORY_SCOPE_AGENT); }
__device__ __forceinline__ unsigned xb_xcc_id() { return (unsigned)__builtin_amdgcn_s_getreg((3 << 11) | 20) & 0xFu; }
#define XB_SPIN(cond, bar) do { unsigned _sp = 0; while (cond) { __builtin_amdgcn_s_sleep(1); \
    if ((++_sp & 255u) == 0u) { if (xb_ld(&(bar)[XB_TMO])) break; if (_sp > XB_SPIN_CAP) { atomicAdd(&(bar)[XB_TMO], 1u); break; } } } } while (0)

struct XcdBarrier { unsigned* bar; unsigned x; volatile LAS unsigned* st; };
__device__ __forceinline__ XcdBarrier xcd_barrier_post(unsigned* bar, volatile LAS unsigned* st) {
    XcdBarrier b; b.bar = bar; b.x = xb_xcc_id(); b.st = st;
    if (threadIdx.x == 0) { const unsigned r_ = xb_add(&bar[XB_XCNT(b.x)], 1u); st[2] = r_; }
    return b;
}
__device__ __forceinline__ void xcd_barrier_complete(unsigned* bar, unsigned x, unsigned& nloc, unsigned& nx) {
    const unsigned G = gridDim.x * gridDim.y * gridDim.z;
    unsigned sum, cnt, mine, sp = 0u;
    for (;;) {
        sum = 0u; cnt = 0u; mine = 0u;
#pragma unroll
        for (unsigned j = 0; j < 16; ++j) { const unsigned c = xb_ld(&bar[XB_XCNT(j)]); sum += c; cnt += (c > 0u) ? 1u : 0u; mine = (j == x) ? c : mine; }
        if (sum == G) break;
        __builtin_amdgcn_s_sleep(1);
        if ((++sp & 255u) == 0u) { if (xb_ld(&bar[XB_TMO])) break; if (sp > XB_SPIN_CAP) { atomicAdd(&bar[XB_TMO], 1u); break; } }
    }
    nloc = mine > 0u ? mine : 1u; nx = cnt > 0u ? cnt : 1u;
}

__device__ __forceinline__ void xcd_barrier(const XcdBarrier& b) {
    asm volatile("s_waitcnt vmcnt(0)" ::: "memory");
    __syncthreads();
    if (threadIdx.x == 0) {
        unsigned* bar = b.bar;
        __builtin_amdgcn_s_waitcnt(0);
        unsigned nloc = b.st[0], nx = b.st[1];
        if (nloc == 0u) { xcd_barrier_complete(bar, b.x, nloc, nx); b.st[0] = nloc; b.st[1] = nx; }
        const unsigned old = xb_add(&bar[XB_XSUB(b.x)], 1u);
        const unsigned gen = old / nloc;
        if (old + 1u == (gen + 1u) * nloc) {
            __builtin_amdgcn_fence(__ATOMIC_RELEASE, "agent");
            asm volatile("s_waitcnt vmcnt(0)" ::: "memory");
            const unsigned og = xb_add(&bar[XB_TOP], 1u);
            const unsigned tg = og / nx;
            if (og + 1u == (tg + 1u) * nx) xb_add(&bar[XB_TOPGEN], 1u);
            else XB_SPIN(xb_ld(&bar[XB_TOPGEN]) == tg, bar);
            __builtin_amdgcn_fence(__ATOMIC_ACQUIRE, "agent");
            xb_add(&bar[XB_XGEN(b.x)], 1u);
            asm volatile("s_waitcnt vmcnt(0)" ::: "memory");
        } else {
            XB_SPIN(xb_ld(&bar[XB_XGEN(b.x)]) == gen, bar);
            __builtin_amdgcn_fence(__ATOMIC_ACQUIRE, "agent");
            asm volatile("s_waitcnt vmcnt(0)" ::: "memory");
        }
    }
    __syncthreads();
}

struct Params { const float* in[23]; float* out; unsigned char* ws; int ph_lo, ph_hi, coop, pad; };

struct Frame {
    LAS unsigned char* lds;
    int tid, lane, wave, vcu, G, gw, NGW, bx;
    unsigned char* ws; bf16_t* hnbuf;
    int r0, rstep, rend, xcd, rank;
};

__device__ __forceinline__ void transpose_item(const float* W, int K, int Nsrc, bf16_t* WT, int dst_n0, int src_n0, int nvalid, const float* kgain, int k0, LAS float* scr, int lane) {
    const int srcn = src_n0 + (lane & 31);
#pragma unroll 32
    for (int i = 0; i < 32; ++i) { const int kk = 2 * i + (lane >> 5);
        float v = (srcn < nvalid) ? W[(size_t)(k0 + kk) * Nsrc + srcn] : 0.f;
        if (kgain) v *= kgain[k0 + kk];
        scr[kk * 33 + (lane & 31)] = v; }
    asm volatile("s_waitcnt lgkmcnt(0)" ::: "memory");
    const int c = lane & 7;
#pragma unroll
    for (int j = 0; j < 4; ++j) { const int n = (lane >> 3) + 8 * j; const LAS float* s = scr + (8 * c) * 33 + n;
        u32x4 o; o.x = cvt_pk_bf16(s[0 * 33], s[1 * 33]); o.y = cvt_pk_bf16(s[2 * 33], s[3 * 33]); o.z = cvt_pk_bf16(s[4 * 33], s[5 * 33]); o.w = cvt_pk_bf16(s[6 * 33], s[7 * 33]);
        *(u32x4*)(WT + (size_t)(dst_n0 + n) * K + k0 + 8 * c) = o; }
    asm volatile("s_waitcnt lgkmcnt(0)" ::: "memory");
}

__device__ __forceinline__ void convert_group(const Frame& F, const float* W, int nl, int K, int Nsrc, int Ndst, bf16_t* WT, int kind, const float* kgain, int gain_stride) {
    int tl_ = F.tid; asm volatile("" : "+v"(tl_)); const int lane_l = tl_ & 63;
    LAS float* scr = (LAS float*)(F.lds + F.wave * 16384);
    const int nblk = Ndst / 32, per = (K / 64) * nblk, total = nl * per;
    for (int it = F.gw; it < total; it += F.NGW) {
        const int l = it / per, r = it % per, kb = r / nblk, nb = r % nblk, dn0 = nb * 32;
        int sn0 = dn0;
        if (kind == 1) { const int j = dn0 >> 8, i0 = dn0 & 255; sn0 = (i0 < 128) ? (128 * j + i0) : (D_FF + 128 * j + i0 - 128); }
        transpose_item(W + (size_t)l * K * Nsrc, K, Nsrc, WT + (size_t)l * Ndst * K, dn0, sn0, Nsrc, kgain ? kgain + l * gain_stride : nullptr, kb * 64, scr, lane_l);
    }
}

__device__ __forceinline__ void phase_prologue(const Frame& F, const Params& p) {
    int tl_ = F.tid; asm volatile("" : "+v"(tl_)); const int lane_l = tl_ & 63;
    bf16_t* WB = (bf16_t*)(F.ws + WS_W);
    convert_group(F, p.in[5], 2, 1024, EIN_N, EIN_NP, WB + OW_EIN, 0, nullptr, 0);
    convert_group(F, p.in[8], 2, 384, 768, 768, WB + OW_EUQ, 0, p.in[7], 384);
    convert_group(F, p.in[10], 2, 256, 1024, 1024, WB + OW_EUKV, 0, p.in[9], 256);
    convert_group(F, p.in[11], 2, 1024, 1024, 1024, WB + OW_EOUT, 0, nullptr, 0);
    convert_group(F, p.in[12], 2, 1024, OIN_N, OIN_N, WB + OW_OIN, 0, nullptr, 0);
    convert_group(F, p.in[18], 2, 1024, 1024, 1024, WB + OW_OOUT, 0, nullptr, 0);
    convert_group(F, p.in[19], 4, 1024, 2 * D_FF, 2 * D_FF, WB + OW_UP, 1, nullptr, 0);
    convert_group(F, p.in[22], 4, D_FF, 1024, 1024, WB + OW_DN, 0, nullptr, 0);
    float* cosT = (float*)(F.ws + WS_COS); float* sinT = (float*)(F.ws + WS_SIN);
    for (int e = F.bx * NTHREADS + F.tid; e < SEQ * 16; e += F.G * NTHREADS) {
        const int pos = e >> 4, i = e & 15;
        const float inv = exp2f(-(float)i * 0.8304820237218406f);
        const float ang = (float)pos * inv;
        const float kq = rintf(ang * 0.6366197723675814f);
        float r = fmaf(-kq, 1.5703125f, ang); r = fmaf(-kq, 4.837512969970703125e-4f, r); r = fmaf(-kq, 7.54978995489188216e-8f, r);
        const float r2_ = r * r;
        const float sn = r + r * r2_ * (-1.6666666667e-1f + r2_ * (8.3333333333e-3f + r2_ * (-1.9841269841e-4f + r2_ * 2.7557319224e-6f)));
        const float cs = 1.0f + r2_ * (-0.5f + r2_ * (4.1666666667e-2f + r2_ * (-1.3888888889e-3f + r2_ * (2.4801587302e-5f + r2_ * -2.7557319224e-7f))));
        const int q4 = ((int)kq) & 3;
        const float s_ = (q4 == 0) ? sn : (q4 == 1) ? cs : (q4 == 2) ? -sn : -cs;
        const float c_ = (q4 == 0) ? cs : (q4 == 1) ? -sn : (q4 == 2) ? -cs : sn;
        cosT[e] = c_; sinT[e] = s_;
    }
    const float* x = p.in[0]; const float* g = p.in[1]; bf16_t* hn = F.hnbuf;
    f32x4 gg[4]; gg[0] = *(const f32x4*)(g + 8 * lane_l); gg[1] = *(const f32x4*)(g + 8 * lane_l + 4); gg[2] = *(const f32x4*)(g + 512 + 8 * lane_l); gg[3] = *(const f32x4*)(g + 512 + 8 * lane_l + 4);
    for (int row = F.r0; row < F.rend; row += 2 * F.rstep) {
        f32x4 v[2][4]; float ss[2];
#pragma unroll
        for (int q = 0; q < 2; ++q) { const float* xr = x + (size_t)(row + q * F.rstep) * 1024;
            v[q][0] = *(const f32x4*)(xr + 8 * lane_l); v[q][1] = *(const f32x4*)(xr + 8 * lane_l + 4); v[q][2] = *(const f32x4*)(xr + 512 + 8 * lane_l); v[q][3] = *(const f32x4*)(xr + 512 + 8 * lane_l + 4); }
#pragma unroll
        for (int q = 0; q < 2; ++q) { ss[q] = 0.f;
#pragma unroll
            for (int j = 0; j < 4; ++j) ss[q] += v[q][j][0] * v[q][j][0] + v[q][j][1] * v[q][j][1] + v[q][j][2] * v[q][j][2] + v[q][j][3] * v[q][j][3]; }
#pragma unroll
        for (int o = 1; o < 64; o <<= 1) { ss[0] += shflx(ss[0], o, lane_l); ss[1] += shflx(ss[1], o, lane_l); }
#pragma unroll
        for (int q = 0; q < 2; ++q) {
            const float r = rsqrtf(ss[q] * (1.0f / 1024.0f) + RMS_EPS);
            f32x4 y[4];
#pragma unroll
            for (int j = 0; j < 4; ++j) y[j] = v[q][j] * r * gg[j];
            u32x4 w0, w1;
            w0.x = cvt_pk_bf16(y[0][0], y[0][1]); w0.y = cvt_pk_bf16(y[0][2], y[0][3]); w0.z = cvt_pk_bf16(y[1][0], y[1][1]); w0.w = cvt_pk_bf16(y[1][2], y[1][3]);
            w1.x = cvt_pk_bf16(y[2][0], y[2][1]); w1.y = cvt_pk_bf16(y[2][2], y[2][3]); w1.z = cvt_pk_bf16(y[3][0], y[3][1]); w1.w = cvt_pk_bf16(y[3][2], y[3][3]);
            const size_t ro = (size_t)(row + q * F.rstep) * 1024;
            *(u32x4*)(hn + ro + 8 * lane_l) = w0; *(u32x4*)(hn + ro + 512 + 8 * lane_l) = w1;
        }
    }
}

template <bool XIN_F32, bool XOUT_F32>
__device__ __forceinline__ void phase_rowpost(const Frame& F, const bf16_t* mb, const void* xin_, void* xout_, const float* gpost, const float* gnext, bf16_t* hn) {
    int tl_ = F.tid; asm volatile("" : "+v"(tl_)); const int lane_l = tl_ & 63;
    const int c0 = 8 * lane_l, c1 = 512 + 8 * lane_l;
    f32x4 gp[4]; gp[0] = *(const f32x4*)(gpost + c0); gp[1] = *(const f32x4*)(gpost + c0 + 4); gp[2] = *(const f32x4*)(gpost + c1); gp[3] = *(const f32x4*)(gpost + c1 + 4);
    f32x4 gn[4];
#pragma unroll
    for (int j = 0; j < 4; ++j) gn[j] = (f32x4){0.f, 0.f, 0.f, 0.f};
    if (gnext) { gn[0] = *(const f32x4*)(gnext + c0); gn[1] = *(const f32x4*)(gnext + c0 + 4); gn[2] = *(const f32x4*)(gnext + c1); gn[3] = *(const f32x4*)(gnext + c1 + 4); }
    for (int row = F.r0; row < F.rend; row += 2 * F.rstep) {
        size_t ro[2]; ro[0] = (size_t)row * 1024; ro[1] = (size_t)(row + F.rstep) * 1024;
        u32x4 m0[2], m1[2]; f32x4 xv[2][4];
#pragma unroll
        for (int q = 0; q < 2; ++q) {
            m0[q] = *(const u32x4*)(mb + ro[q] + c0); m1[q] = *(const u32x4*)(mb + ro[q] + c1);
            if (XIN_F32) { const float* xin = (const float*)xin_;
                xv[q][0] = *(const f32x4*)(xin + ro[q] + c0); xv[q][1] = *(const f32x4*)(xin + ro[q] + c0 + 4); xv[q][2] = *(const f32x4*)(xin + ro[q] + c1); xv[q][3] = *(const f32x4*)(xin + ro[q] + c1 + 4);
            } else { const bf16_t* xin = (const bf16_t*)xin_;
                const u32x4 a0 = *(const u32x4*)(xin + ro[q] + c0), a1 = *(const u32x4*)(xin + ro[q] + c1);
                xv[q][0] = (f32x4){bf_lo(a0.x), bf_hi(a0.x), bf_lo(a0.y), bf_hi(a0.y)}; xv[q][1] = (f32x4){bf_lo(a0.z), bf_hi(a0.z), bf_lo(a0.w), bf_hi(a0.w)};
                xv[q][2] = (f32x4){bf_lo(a1.x), bf_hi(a1.x), bf_lo(a1.y), bf_hi(a1.y)}; xv[q][3] = (f32x4){bf_lo(a1.z), bf_hi(a1.z), bf_lo(a1.w), bf_hi(a1.w)};
            }
        }
        f32x4 mv[2][4]; float ss[2];
#pragma unroll
        for (int q = 0; q < 2; ++q) {
            mv[q][0] = (f32x4){bf_lo(m0[q].x), bf_hi(m0[q].x), bf_lo(m0[q].y), bf_hi(m0[q].y)}; mv[q][1] = (f32x4){bf_lo(m0[q].z), bf_hi(m0[q].z), bf_lo(m0[q].w), bf_hi(m0[q].w)};
            mv[q][2] = (f32x4){bf_lo(m1[q].x), bf_hi(m1[q].x), bf_lo(m1[q].y), bf_hi(m1[q].y)}; mv[q][3] = (f32x4){bf_lo(m1[q].z), bf_hi(m1[q].z), bf_lo(m1[q].w), bf_hi(m1[q].w)};
            ss[q] = 0.f;
#pragma unroll
            for (int j = 0; j < 4; ++j) ss[q] += mv[q][j][0] * mv[q][j][0] + mv[q][j][1] * mv[q][j][1] + mv[q][j][2] * mv[q][j][2] + mv[q][j][3] * mv[q][j][3];
        }
#pragma unroll
        for (int o = 1; o < 64; o <<= 1) { ss[0] += shflx(ss[0], o, lane_l); ss[1] += shflx(ss[1], o, lane_l); }
        float s2[2];
#pragma unroll
        for (int q = 0; q < 2; ++q) {
            const float r1 = rsqrtf(ss[q] * (1.0f / 1024.0f) + RMS_EPS);
            s2[q] = 0.f;
#pragma unroll
            for (int j = 0; j < 4; ++j) { xv[q][j] = xv[q][j] + mv[q][j] * r1 * gp[j]; s2[q] += xv[q][j][0] * xv[q][j][0] + xv[q][j][1] * xv[q][j][1] + xv[q][j][2] * xv[q][j][2] + xv[q][j][3] * xv[q][j][3]; }
            if (XOUT_F32) { float* xout = (float*)xout_;
                *(f32x4*)(xout + ro[q] + c0) = xv[q][0]; *(f32x4*)(xout + ro[q] + c0 + 4) = xv[q][1]; *(f32x4*)(xout + ro[q] + c1) = xv[q][2]; *(f32x4*)(xout + ro[q] + c1 + 4) = xv[q][3];
            } else { bf16_t* xout = (bf16_t*)xout_; u32x4 w0, w1;
                w0.x = cvt_pk_bf16(xv[q][0][0], xv[q][0][1]); w0.y = cvt_pk_bf16(xv[q][0][2], xv[q][0][3]); w0.z = cvt_pk_bf16(xv[q][1][0], xv[q][1][1]); w0.w = cvt_pk_bf16(xv[q][1][2], xv[q][1][3]);
                w1.x = cvt_pk_bf16(xv[q][2][0], xv[q][2][1]); w1.y = cvt_pk_bf16(xv[q][2][2], xv[q][2][3]); w1.z = cvt_pk_bf16(xv[q][3][0], xv[q][3][1]); w1.w = cvt_pk_bf16(xv[q][3][2], xv[q][3][3]);
                *(u32x4*)(xout + ro[q] + c0) = w0; *(u32x4*)(xout + ro[q] + c1) = w1;
            }
        }
        if (gnext) {
#pragma unroll
            for (int o = 1; o < 64; o <<= 1) { s2[0] += shflx(s2[0], o, lane_l); s2[1] += shflx(s2[1], o, lane_l); }
#pragma unroll
            for (int q = 0; q < 2; ++q) {
                const float r2 = rsqrtf(s2[q] * (1.0f / 1024.0f) + RMS_EPS);
                f32x4 y[4];
#pragma unroll
                for (int j = 0; j < 4; ++j) y[j] = xv[q][j] * r2 * gn[j];
                u32x4 w0, w1;
                w0.x = cvt_pk_bf16(y[0][0], y[0][1]); w0.y = cvt_pk_bf16(y[0][2], y[0][3]); w0.z = cvt_pk_bf16(y[1][0], y[1][1]); w0.w = cvt_pk_bf16(y[1][2], y[1][3]);
                w1.x = cvt_pk_bf16(y[2][0], y[2][1]); w1.y = cvt_pk_bf16(y[2][2], y[2][3]); w1.z = cvt_pk_bf16(y[3][0], y[3][1]); w1.w = cvt_pk_bf16(y[3][2], y[3][3]);
                *(u32x4*)(hn + ro[q] + c0) = w0; *(u32x4*)(hn + ro[q] + c1) = w1;
            }
        }
    }
}

__device__ __forceinline__ float sumsq8(u32x4 v) {
    const float a = bf_lo(v.x), b = bf_hi(v.x), c = bf_lo(v.y), d = bf_hi(v.y), e = bf_lo(v.z), f = bf_hi(v.z), g = bf_lo(v.w), h = bf_hi(v.w);
    return (a * a + b * b) + (c * c + d * d) + (e * e + f * f) + (g * g + h * h);
}

__device__ __forceinline__ void phase_even_small(const Frame& F, const Params& p, int li) {
    int tl_ = F.tid; asm volatile("" : "+v"(tl_)); const int lane_l = tl_ & 63;
    const bf16_t* proj = (const bf16_t*)(F.ws + WS_PROJ);
    float* rq = (float*)(F.ws + WS_RSTDQ); float* rkv = (float*)(F.ws + WS_RSTDKV);
    bf16_t* krope = (bf16_t*)(F.ws + WS_KROPE);
    const float* cosT = (const float*)(F.ws + WS_COS); const float* sinT = (const float*)(F.ws + WS_SIN);
    for (int t0 = F.r0; t0 < F.rend; t0 += 4 * F.rstep) {
        u32x4 cq[4], ckv[4]; float x1[4], x2[4], cs[4], sn[4];
#pragma unroll
        for (int q = 0; q < 4; ++q) {
            const int t = t0 + q * F.rstep; const bf16_t* pr = proj + (size_t)t * EIN_NP;
            cq[q] = (u32x4){0, 0, 0, 0}; ckv[q] = (u32x4){0, 0, 0, 0}; x1[q] = 0.f; x2[q] = 0.f; cs[q] = 0.f; sn[q] = 0.f;
            if (lane_l < 48) cq[q] = *(const u32x4*)(pr + C_CQ + 8 * lane_l);
            if (lane_l < 32) ckv[q] = *(const u32x4*)(pr + C_CKV + 8 * lane_l);
            if (lane_l < 16) { x1[q] = bf2f(pr[C_KR + lane_l]); x2[q] = bf2f(pr[C_KR + 16 + lane_l]); const int pos = t & (SEQ - 1); cs[q] = cosT[pos * 16 + lane_l]; sn[q] = sinT[pos * 16 + lane_l]; }
        }
        float sq[4], skv[4];
#pragma unroll
        for (int q = 0; q < 4; ++q) { sq[q] = sumsq8(cq[q]); skv[q] = sumsq8(ckv[q]); }
#pragma unroll
        for (int o = 1; o < 64; o <<= 1) {
#pragma unroll
            for (int q = 0; q < 4; ++q) { sq[q] += shflx(sq[q], o, lane_l); skv[q] += shflx(skv[q], o, lane_l); }
        }
#pragma unroll
        for (int q = 0; q < 4; ++q) {
            const int t = t0 + q * F.rstep;
            if (lane_l == 0) { rq[t] = rsqrtf(sq[q] * (1.0f / 384.0f) + RMS_EPS); rkv[t] = rsqrtf(skv[q] * (1.0f / 256.0f) + RMS_EPS); }
            if (lane_l < 16) {
                const unsigned a = cvt_pk_bf16(x1[q] * cs[q] - x2[q] * sn[q], x1[q] * sn[q] + x2[q] * cs[q]);
                krope[(size_t)t * 32 + lane_l] = (bf16_t)(a & 0xffffu); krope[(size_t)t * 32 + 16 + lane_l] = (bf16_t)(a >> 16);
            }
        }
    }
    float* ccum = (float*)(F.ws + WS_CCUM);
    LAS float* tot = (LAS float*)(F.lds);
    for (int bh = F.bx; bh < 64; bh += F.G) {
        const int b = bh >> 3, h = bh & 7;
        const float bf = p.in[6][li * 8 + h];
        float v[8]; float carry = 0.f;
#pragma unroll
        for (int j = 0; j < 8; ++j) {
            const int s = 512 * F.wave + 64 * j + lane_l;
            const float xg = bf2f(proj[((size_t)b * SEQ + s) * EIN_NP + C_FG + h]) + bf;
            float ls = (xg >= 0.f) ? -log1pf(expf(-xg)) : (xg - log1pf(expf(xg)));
#pragma unroll
            for (int d = 1; d < 64; d <<= 1) { const float t_ = __int_as_float(__builtin_amdgcn_ds_bpermute(((lane_l - d) & 63) << 2, __float_as_int(ls))); if (lane_l >= d) ls += t_; }
            v[j] = ls + carry;
            carry = __int_as_float(__builtin_amdgcn_readlane(__float_as_int(v[j]), 63));
        }
        __syncthreads();
        if (lane_l == 0) tot[F.wave] = carry;
        __syncthreads();
        float off = 0.f;
#pragma unroll
        for (int w = 0; w < 8; ++w) { const float tw = tot[w]; if (w < F.wave) off += tw; }
#pragma unroll
        for (int j = 0; j < 8; ++j) ccum[(size_t)bh * SEQ + 512 * F.wave + 64 * j + lane_l] = (v[j] + off) * LOG2E;
    }
}

__device__ __forceinline__ void phase_odd_post(const Frame& F, const Params& p, int layer) {
    int tl_ = F.tid; asm volatile("" : "+v"(tl_)); const int lane_l = tl_ & 63;
    const int li = layer >> 1;
    const float linit = 0.8f - 0.6f * expf(-0.3f * (float)layer);
    const float s1 = wave_sum(p.in[13][li * 64 + lane_l] * p.in[14][li * 64 + lane_l], lane_l);
    const float s2 = wave_sum(p.in[15][li * 64 + lane_l] * p.in[16][li * 64 + lane_l], lane_l);
    const float lam = expf(s1) - expf(s2) + linit;
    const bf16_t* Oa = (const bf16_t*)(F.ws + WS_R2); const bf16_t* Ob = (const bf16_t*)(F.ws + WS_R2 + R2_OB);
    bf16_t* outb = F.hnbuf;
    const float* sub = p.in[17] + li * 128 + (16 * lane_l & 127);
    f32x4 sg[4];
#pragma unroll
    for (int j = 0; j < 4; ++j) sg[j] = *(const f32x4*)(sub + 4 * j) * (1.0f - linit);
    for (int row = F.r0; row < F.rend; row += 2 * F.rstep) {
        size_t ro[2]; ro[0] = (size_t)row * 1024 + 16 * lane_l; ro[1] = (size_t)(row + F.rstep) * 1024 + 16 * lane_l;
        u32x4 a0[2], a1[2], b0[2], b1[2];
#pragma unroll
        for (int q = 0; q < 2; ++q) { a0[q] = *(const u32x4*)(Oa + ro[q]); a1[q] = *(const u32x4*)(Oa + ro[q] + 8); b0[q] = *(const u32x4*)(Ob + ro[q]); b1[q] = *(const u32x4*)(Ob + ro[q] + 8); }
#pragma unroll
        for (int q = 0; q < 2; ++q) {
            f32x4 v[4];
            v[0] = (f32x4){bf_lo(a0[q].x) - lam * bf_lo(b0[q].x), bf_hi(a0[q].x) - lam * bf_hi(b0[q].x), bf_lo(a0[q].y) - lam * bf_lo(b0[q].y), bf_hi(a0[q].y) - lam * bf_hi(b0[q].y)};
            v[1] = (f32x4){bf_lo(a0[q].z) - lam * bf_lo(b0[q].z), bf_hi(a0[q].z) - lam * bf_hi(b0[q].z), bf_lo(a0[q].w) - lam * bf_lo(b0[q].w), bf_hi(a0[q].w) - lam * bf_hi(b0[q].w)};
            v[2] = (f32x4){bf_lo(a1[q].x) - lam * bf_lo(b1[q].x), bf_hi(a1[q].x) - lam * bf_hi(b1[q].x), bf_lo(a1[q].y) - lam * bf_lo(b1[q].y), bf_hi(a1[q].y) - lam * bf_hi(b1[q].y)};
            v[3] = (f32x4){bf_lo(a1[q].z) - lam * bf_lo(b1[q].z), bf_hi(a1[q].z) - lam * bf_hi(b1[q].z), bf_lo(a1[q].w) - lam * bf_lo(b1[q].w), bf_hi(a1[q].w) - lam * bf_hi(b1[q].w)};
            float ss = 0.f;
#pragma unroll
            for (int j = 0; j < 4; ++j) ss += v[j][0] * v[j][0] + v[j][1] * v[j][1] + v[j][2] * v[j][2] + v[j][3] * v[j][3];
            ss += shflx(ss, 1, lane_l); ss += shflx(ss, 2, lane_l); ss += shflx(ss, 4, lane_l);
            const float r = rsqrtf(ss * (1.0f / 128.0f) + RMS_EPS);
#pragma unroll
            for (int j = 0; j < 4; ++j) v[j] = v[j] * r * sg[j];
            u32x4 w0, w1;
            w0.x = cvt_pk_bf16(v[0][0], v[0][1]); w0.y = cvt_pk_bf16(v[0][2], v[0][3]); w0.z = cvt_pk_bf16(v[1][0], v[1][1]); w0.w = cvt_pk_bf16(v[1][2], v[1][3]);
            w1.x = cvt_pk_bf16(v[2][0], v[2][1]); w1.y = cvt_pk_bf16(v[2][2], v[2][3]); w1.z = cvt_pk_bf16(v[3][0], v[3][1]); w1.w = cvt_pk_bf16(v[3][2], v[3][3]);
            *(u32x4*)(outb + ro[q]) = w0; *(u32x4*)(outb + ro[q] + 8) = w1;
        }
    }
}

__device__ __forceinline__ void phase_ffn_fix(const Frame& F, const float* cw, const float* cb) {
    const float* halo = (const float*)(F.ws + WS_R2 + R2_HALO); const float* part = (const float*)(F.ws + WS_R2 + R2_PART); const float* val01 = (const float*)(F.ws + WS_R2 + R2_VAL);
    bf16_t* act = (bf16_t*)(F.ws + WS_PROJ);
    constexpr int CG = D_FF / 4, TOT = (MTOK / 64) * 2 * CG;
    const bool byx = (F.G == 256);
    for (int it = (byx ? F.rank : F.bx) * NTHREADS + F.tid; it < (byx ? TOT / 8 : TOT); it += (byx ? 32 : F.G) * NTHREADS) {
        const int cgi = it % CG, rr = (it / CG) & 1, chunk = (byx ? F.xcd * 64 : 0) + it / (2 * CG), col = 4 * cgi;
        const int prev = chunk > 0 ? chunk - 1 : 0; const float hm = (chunk & 63) ? 1.0f : 0.0f;
        f32x4 cv = *(const f32x4*)(part + (size_t)(chunk * 2 + rr) * D_FF + col);
        const f32x4 v = *(const f32x4*)(val01 + (size_t)(chunk * 2 + rr) * D_FF + col);
        const f32x4 h0 = *(const f32x4*)(halo + (size_t)(prev * 2 + 0) * D_FF + col), h1 = *(const f32x4*)(halo + (size_t)(prev * 2 + 1) * D_FF + col);
        const f32x4 w0 = *(const f32x4*)(cw + col), w1 = *(const f32x4*)(cw + D_FF + col);
        const f32x4 add = (rr == 0) ? (w1 * h1 + w0 * h0) : (w0 * h1);
        cv = cv + add * hm;
        u32x2 w; w.x = cvt_pk_bf16(gelu_tanh(cv[0]) * v[0], gelu_tanh(cv[1]) * v[1]); w.y = cvt_pk_bf16(gelu_tanh(cv[2]) * v[2], gelu_tanh(cv[3]) * v[3]);
        *(u32x2*)(act + (size_t)(chunk * 64 + rr) * D_FF + col) = w;
    }
}

__device__ __forceinline__ void phase_attn_even(const Frame& F, const int pm) {
    const bf16_t* proj = (const bf16_t*)(F.ws + WS_PROJ);
    const bf16_t* qmla = (const bf16_t*)(F.ws + WS_R2); const bf16_t* kvmla = (const bf16_t*)(F.ws + WS_R2 + R2_KVMLA);
    const bf16_t* krope = (const bf16_t*)(F.ws + WS_KROPE);
    bf16_t* ao = F.hnbuf;
    const float* ccum = (const float*)(F.ws + WS_CCUM);
    for (int it_ = 0; it_ < (F.G == 256 ? 4 : (1024 + F.G - 1) / F.G); ++it_) {
        int item;
        if (F.G == 256) { const int li = F.rank + 32 * it_; item = (li >> 6) * 512 + (F.xcd * 8 + ((li & 63) >> 3)) * 8 + (li & 7); }
        else { item = F.vcu + it_ * F.G; if (item >= 1024) break; }
        const int stream = item >> 9, rem = item & 511, bh = rem >> 3, pr = rem & 7, b = bh >> 3, h = bh & 7;
        const size_t rowbase = (size_t)b * SEQ;
        AttnP P;
        if (stream == 0) {
            P.Q = proj + C_FQ + h * 64; P.ldq = EIN_NP; P.K1 = proj + C_FK + h * 64; P.ldk1 = EIN_NP; P.K2 = nullptr; P.V = proj + C_FV + h * 64; P.ldv = EIN_NP;
            P.O = ao + h * 64; P.ldo = 1024; P.bias = ccum + (size_t)bh * SEQ; P.sl2 = 0.f; P.Oprev = nullptr; P.subln = nullptr; P.lam = 0.f; P.osc = 0.f;
            attn_unit<64, 64, 0>(F.lds, P, rowbase, 15 - pr, F.tid, pm);
            attn_unit<64, 64, 0>(F.lds, P, rowbase, pr, F.tid, pm);
        } else {
            P.Q = qmla + h * 96; P.ldq = 768; P.K1 = kvmla + h * 128; P.ldk1 = 1024; P.K2 = krope; P.V = kvmla + h * 128 + 64; P.ldv = 1024;
            P.O = ao + 512 + h * 64; P.ldo = 1024; P.bias = nullptr; P.sl2 = 0.f; P.Oprev = nullptr; P.subln = nullptr; P.lam = 0.f; P.osc = 0.f;
            attn_unit<96, 64, 1>(F.lds, P, rowbase, 15 - pr, F.tid, pm);
            attn_unit<96, 64, 1>(F.lds, P, rowbase, pr, F.tid, pm);
        }
    }
}
__device__ __forceinline__ void phase_attn_odd(const Frame& F, const Params& p, const int layer, const int pm) {
    int tid_l = F.tid; asm volatile("" : "+v"(tid_l));
    const int lane_l = tid_l & 63, li_ = layer >> 1;
    const bf16_t* proj = (const bf16_t*)(F.ws + WS_PROJ);
    bf16_t* Oa = (bf16_t*)(F.ws + WS_R2); bf16_t* ao = F.hnbuf;
    const float linit = 0.8f - 0.6f * expf(-0.3f * (float)layer);
    const float s1 = wave_sum(p.in[13][li_ * 64 + lane_l] * p.in[14][li_ * 64 + lane_l], lane_l);
    const float s2 = wave_sum(p.in[15][li_ * 64 + lane_l] * p.in[16][li_ * 64 + lane_l], lane_l);
    const float lam = expf(s1) - expf(s2) + linit;
    for (int it_ = 0; it_ < (F.G == 256 ? 2 : (512 + F.G - 1) / F.G); ++it_) {
        int item;
        if (F.G == 256) { const int li = F.rank + 32 * it_; item = (F.xcd * 8 + (li >> 3)) * 8 + (li & 7); }
        else { item = F.vcu + it_ * F.G; if (item >= 512) break; }
        const int bh = item >> 3, pr = item & 7, b = bh >> 3, h = bh & 7;
        const size_t rowbase = (size_t)b * SEQ;
        for (int half = 0; half < 2; ++half) {
            const int qb = half ? pr : 15 - pr;
            for (int w2 = 0; w2 < 2; ++w2) {
                const int hp = 2 * h + w2;
                AttnP P;
                P.Q = proj + hp * 64; P.ldq = OIN_N; P.K1 = proj + 1024 + hp * 64; P.ldk1 = OIN_N; P.K2 = nullptr; P.V = proj + 2048 + h * 128; P.ldv = OIN_N;
                P.ldo = 1024; P.bias = nullptr; P.sl2 = exp2f(-(float)(h + 1)) * LOG2E;
                P.O = (w2 ? ao : Oa) + h * 128; P.Oprev = w2 ? (const bf16_t*)(Oa + h * 128) : nullptr;
                P.subln = p.in[17] + li_ * 128; P.lam = lam; P.osc = 1.0f - linit;
                attn_unit<64, 128, 2>(F.lds, P, rowbase, qb, tid_l, pm);
            }
        }
    }
}

#ifndef PHMASK
#define PHMASK 0xffff
#endif
#ifndef PROBEMODE
#define PROBEMODE 0
#endif
#ifndef SYNC2
#define SYNC2 0
#endif
#ifndef REPMASK
#define REPMASK 0
#endif
enum { K_PRO = 0, K_GIN = 1, K_ESMALL = 2, K_EGEMM = 3, K_ATTN = 4, K_OPOST = 5, K_GOUT = 6, K_ROWMIX = 7, K_F1 = 8, K_F2 = 9, K_F3 = 10, K_ROWFFN = 11 };
constexpr int NPHASES = 1 + 2 * 18;

__global__ void __launch_bounds__(NTHREADS) mega_kernel(Params p_) {
    extern __shared__ __attribute__((aligned(16))) unsigned char lds_raw[];
    const int ph_lo = p_.ph_lo, ph_hi = p_.ph_hi, coop = p_.coop;
    const int wave_s = __builtin_amdgcn_readfirstlane((int)threadIdx.x >> 6);
    if (coop) {
        volatile LAS unsigned* st_ = (volatile LAS unsigned*)((LAS unsigned char*)lds_raw + 131072 + 64);
        if (threadIdx.x < 4) st_[threadIdx.x] = (threadIdx.x == 3) ? blockIdx.x : 0u;
        __syncthreads();
        (void)xcd_barrier_post((unsigned*)p_.ws, st_);
    } else {
        volatile LAS unsigned* st_ = (volatile LAS unsigned*)((LAS unsigned char*)lds_raw + 131072 + 64);
        if (threadIdx.x == 0) st_[3] = blockIdx.x;
        __syncthreads();
    }
    int rep_done = 0;
    for (int ph = ph_lo; ph < ph_hi; ) {
    const __attribute__((address_space(4))) Params* pp_ = (const __attribute__((address_space(4))) Params*)__builtin_amdgcn_kernarg_segment_ptr(); asm volatile("" : "+s"(pp_));
    const Params& p = *(const Params*)pp_;
    Frame F;
    F.lds = (LAS unsigned char*)lds_raw;
    { int ws_ = wave_s; asm volatile("" : "+s"(ws_)); unsigned z_ = 0u; asm volatile("" : "+s"(z_)); int t_ = ws_ * 64 + (int)__builtin_amdgcn_mbcnt_hi(~0u, __builtin_amdgcn_mbcnt_lo(~0u, z_)); asm volatile("" : "+v"(t_)); F.tid = t_; }
    F.lane = F.tid & 63; F.wave = __builtin_amdgcn_readfirstlane(F.tid >> 6);
    { unsigned a_ = 131072u + 64u + 12u; asm volatile("" : "+v"(a_)); int b_ = __builtin_amdgcn_readfirstlane((int)*(volatile LAS unsigned*)(F.lds + a_)); asm volatile("" : "+s"(b_)); F.bx = b_; }
    F.G = gridDim.x; { const int bx = F.bx; F.vcu = (F.G % 8 == 0) ? (bx % 8) * (F.G / 8) + bx / 8 : bx; }
    F.gw = F.vcu * NWAVES + F.wave; F.NGW = F.G * NWAVES;
    F.xcd = F.bx & 7; F.rank = F.bx >> 3;
    if (F.G == 256) { F.r0 = F.xcd * SEQ + F.rank * NWAVES + F.wave; F.rstep = 256; F.rend = (F.xcd + 1) * SEQ; }
    else { F.r0 = F.gw; F.rstep = F.NGW; F.rend = MTOK; }
    F.ws = p.ws;
    bf16_t* WB = (bf16_t*)(F.ws + WS_W);
    F.hnbuf = (bf16_t*)p.out;
    bf16_t* hn = F.hnbuf;
    bf16_t* xb = (bf16_t*)(F.ws + WS_HN);
    bf16_t* proj = (bf16_t*)(F.ws + WS_PROJ);
    bf16_t* r2 = (bf16_t*)(F.ws + WS_R2);
        int layer = 0, kind = K_PRO;
        if (ph > 0) { const int r = ph - 1, pi = r / 18, rr = r % 18; const bool odd = rr >= 10; layer = 2 * pi + (odd ? 1 : 0); const int idx = odd ? rr - 10 : rr;
            kind = odd ? (idx == 0 ? K_GIN : idx == 1 ? K_ATTN : idx + 4) : (idx < 4 ? idx + 1 : idx + 2); }
        const int li = layer >> 1; const bool oddl = layer & 1;
        const int pm_ = (PROBEMODE && !rep_done) ? PROBEMODE : 0;
        if (kind == K_PRO) {
            if (PHMASK & 1) phase_prologue(F, p);
        } else if (kind == K_GIN || kind == K_GOUT || kind == K_F3) {
            pg8::Gemm g; EpiStore E; E.rowscale = nullptr; E.rs_mul = 1.f; E.ropec = nullptr; E.ropes = nullptr; E.s0 = 0.125f * LOG2E; E.scale_cols = 0;
            if (kind == K_GIN) {
                if (!oddl) { g = pg8::Gemm{hn, WB + OW_EIN + (size_t)li * EIN_NP * 1024, MTOK, EIN_NP, 1024, 1024, 1024}; E.O = proj; E.ldc = EIN_NP; E.scale_cols = 512; }
                else { g = pg8::Gemm{hn, WB + OW_OIN + (size_t)li * OIN_N * 1024, MTOK, OIN_N, 1024, 1024, 1024}; E.O = proj; E.ldc = OIN_N; E.scale_cols = 1024; }
            } else if (kind == K_GOUT) {
                g = pg8::Gemm{hn, WB + (oddl ? OW_OOUT : OW_EOUT) + (size_t)li * 1024 * 1024, MTOK, 1024, 1024, 1024, 1024}; E.O = r2; E.ldc = 1024;
            } else {
                g = pg8::Gemm{proj, WB + OW_DN + (size_t)layer * 1024 * D_FF, MTOK, 1024, D_FF, D_FF, D_FF}; E.O = r2; E.ldc = 1024;
            }
            pg8::StaticOrder S; S.init(g.M, g.N, F.G, F.bx);
            if (PHMASK & 2) pg8::gemm_phase<EpiStore, pg8::StaticOrder, true>(F.lds, g, S, E, F.tid);
        } else if (kind == K_ESMALL) {
            if (PHMASK & 4) phase_even_small(F, p, li);
        } else if (kind == K_EGEMM) {
            for (int which = 0; which < 2; ++which) {
                pg8::Gemm g; EpiStore E; E.scale_cols = 0; E.s0 = 1.f;
                if (which == 0) { g = pg8::Gemm{proj + C_CQ, WB + OW_EUQ + (size_t)li * 768 * 384, MTOK, 768, 384, EIN_NP, 384};
                    E.O = r2; E.ldc = 768; E.rowscale = (const float*)(F.ws + WS_RSTDQ); E.rs_mul = 0.10206207261596577f * LOG2E; E.ropec = (const float*)(F.ws + WS_COS); E.ropes = (const float*)(F.ws + WS_SIN); }
                else { g = pg8::Gemm{proj + C_CKV, WB + OW_EUKV + (size_t)li * 1024 * 256, MTOK, 1024, 256, EIN_NP, 256};
                    E.O = (bf16_t*)(F.ws + WS_R2 + R2_KVMLA); E.ldc = 1024; E.rowscale = (const float*)(F.ws + WS_RSTDKV); E.rs_mul = 1.f; E.ropec = nullptr; E.ropes = nullptr; }
                pg8::StaticOrder S; S.init(g.M, g.N, F.G, F.bx);
                if (PHMASK & 8) pg8::gemm_phase<EpiStore, pg8::StaticOrder, true>(F.lds, g, S, E, F.tid);
            }
        } else if (kind == K_ATTN) {
            if (!oddl) { if (PHMASK & 16) phase_attn_even(F, pm_); } else { if (PHMASK & 32) phase_attn_odd(F, p, layer, pm_); }
        } else if (kind == K_OPOST) {
            if (PHMASK & 64) phase_odd_post(F, p, layer);
        } else if (kind == K_ROWMIX) {
            if (layer == 0) phase_rowpost<true, false>(F, r2, p.in[0], xb, p.in[2] + layer * 1024, p.in[3] + layer * 1024, hn);
            else phase_rowpost<false, false>(F, r2, xb, xb, p.in[2] + layer * 1024, p.in[3] + layer * 1024, hn);
        } else if (kind == K_F1) {
            pg8::Gemm g{hn, WB + OW_UP + (size_t)layer * 5632 * 1024, MTOK, 2 * D_FF, 1024, 1024, 1024};
            EpiConv E{proj, p.in[20] + (size_t)layer * 3 * D_FF, p.in[21] + (size_t)layer * D_FF, (float*)(F.ws + WS_R2 + R2_HALO), (float*)(F.ws + WS_R2 + R2_PART), (float*)(F.ws + WS_R2 + R2_VAL)};
            pg8::StaticOrder S; S.init(g.M, g.N, F.G, F.bx);
            if (PHMASK & 256) pg8::gemm_phase<EpiConv, pg8::StaticOrder, true>(F.lds, g, S, E, F.tid);
        } else if (kind == K_F2) {
            if (PHMASK & 512) phase_ffn_fix(F, p.in[20] + (size_t)layer * 3 * D_FF, p.in[21] + (size_t)layer * D_FF);
        } else if (kind == K_ROWFFN) {
            if (layer + 1 < DEPTH) phase_rowpost<false, false>(F, r2, xb, xb, p.in[4] + layer * 1024, p.in[1] + (layer + 1) * 1024, hn);
            else phase_rowpost<false, true>(F, r2, xb, p.out, p.in[4] + layer * 1024, nullptr, hn);
        }
        if (coop && ph + 1 < ph_hi) {
            if (ph == 0) {
                cg::this_grid().sync();
                volatile LAS unsigned* st_ = (volatile LAS unsigned*)(F.lds + 131072 + 64);
                if (threadIdx.x == 0) {
                    unsigned* bar_ = (unsigned*)F.ws; bool ok_ = (gridDim.x % 8u) == 0u;
                    for (unsigned j = 0; j < 16; ++j) { const unsigned c_ = xb_ld(&bar_[XB_XCNT(j)]); ok_ = ok_ && (c_ == (j < 8u ? gridDim.x / 8u : 0u)); }
                    const unsigned x_ = xb_xcc_id();
                    st_[3] = (ok_ && x_ < 8u && st_[2] < gridDim.x / 8u) ? (st_[2] * 8u + x_) : blockIdx.x;
                }
                __syncthreads();
            }
            else { XcdBarrier xb_; xb_.bar = (unsigned*)F.ws; xb_.x = xb_xcc_id(); xb_.st = (volatile LAS unsigned*)(F.lds + 131072 + 64); xcd_barrier(xb_); if (SYNC2) xcd_barrier(xb_); }
        }
        if (((REPMASK >> kind) & 1) && !rep_done) { rep_done = 1; } else { rep_done = 0; ++ph; }
    }
}

#ifndef MK_MULTI
#define MK_MULTI 0
#endif

extern "C" void kernel_launch(void* const* d_in, const int* in_sizes, int n_in, void* d_out, int out_size, void* d_ws, size_t ws_size, hipStream_t stream) {
    static int grid = 0;
    if (grid == 0) {
        if (n_in != 23 || out_size != MTOK * D_MODEL || ws_size < WS_END) { fprintf(stderr, "kernel_launch: unexpected shapes (n_in %d out %d ws %zu need %zu)\n", n_in, out_size, ws_size, (size_t)WS_END); grid = -1; return; }
        int dev = 0, cus = 0, per_cu = 0;
        hipGetDevice(&dev); hipDeviceGetAttribute(&cus, hipDeviceAttributeMultiprocessorCount, dev);
        if (hipFuncSetAttribute((const void*)mega_kernel, hipFuncAttributeMaxDynamicSharedMemorySize, LDS_BYTES) != hipSuccess) { fprintf(stderr, "kernel_launch: hipFuncSetAttribute failed\n"); grid = -1; return; }
        hipOccupancyMaxActiveBlocksPerMultiprocessor(&per_cu, (const void*)mega_kernel, NTHREADS, LDS_BYTES);
        (void)hipGetLastError();
        if (per_cu < 1) fprintf(stderr, "kernel_launch: occupancy query says %d blocks/CU\n", per_cu);
        grid = cus;
    }
    if (grid < 0) return;
    Params p{};
    for (int i = 0; i < 23; ++i) p.in[i] = (const float*)d_in[i];
    p.out = (float*)d_out; p.ws = (unsigned char*)d_ws;
#if MK_MULTI
    for (int ph = 0; ph < NPHASES; ++ph) {
        p.ph_lo = ph; p.ph_hi = ph + 1; p.coop = 0;
        hipLaunchKernelGGL(mega_kernel, dim3(grid), dim3(NTHREADS), LDS_BYTES, stream, p);
    }
#else
    if (hipMemsetAsync(d_ws, 0, 65536, stream) != hipSuccess) { fprintf(stderr, "memset failed\n"); return; }
    p.ph_lo = 0; p.ph_hi = NPHASES; p.coop = 1;
    void* args[] = {&p};
    hipError_t e = hipLaunchCooperativeKernel((const void*)mega_kernel, dim3(grid), dim3(NTHREADS), args, LDS_BYTES, stream);
    if (e != hipSuccess) fprintf(stderr, "cooperative launch failed: %s (grid %d)\n", hipGetErrorString(e), grid);
#endif
}
```

```cpp
#include <hip/hip_runtime.h>
#include <hip/hip_cooperative_groups.h>
#include <cstdio>
#include <cstdint>
namespace cg = cooperative_groups;

#define LAS __attribute__((address_space(3)))
#ifndef KPF2
#define KPF2 true
#endif
typedef unsigned short bf16_t;
typedef short bf16x8 __attribute__((ext_vector_type(8)));
typedef short s16x4 __attribute__((ext_vector_type(4)));
typedef float f32x4 __attribute__((ext_vector_type(4)));
typedef float f32x16 __attribute__((ext_vector_type(16)));
typedef unsigned u32x4 __attribute__((ext_vector_type(4)));
typedef unsigned u32x2 __attribute__((ext_vector_type(2)));

constexpr int D_MODEL = 1024, BATCH = 8, SEQ = 4096, DEPTH = 4, MTOK = BATCH * SEQ;
constexpr int D_FF = 2816;
constexpr int EIN_N = 2216, EIN_NP = 2304;
constexpr int OIN_N = 3072;
constexpr float RMS_EPS = 1e-6f;
constexpr float LOG2E = 1.4426950408889634f;
constexpr float NEGBIG = -1e30f;
constexpr int C_FQ = 0, C_FK = 512, C_FV = 1024, C_FG = 1536, C_CQ = 1544, C_CKV = 1928, C_KR = 2184;

constexpr size_t MiB = 1u << 20;
constexpr size_t WS_RSTDQ = 128 * 1024, WS_RSTDKV = 256 * 1024;
constexpr size_t WS_CCUM = 1 * MiB, WS_KROPE = 2 * MiB, WS_COS = 4 * MiB, WS_SIN = 4 * MiB + 512 * 1024;
constexpr size_t WS_W = 8 * MiB;
constexpr size_t WS_HN = 112 * MiB;
constexpr size_t WS_PROJ = 176 * MiB;
constexpr size_t WS_R2 = 368 * MiB;
constexpr size_t WS_END = 496 * MiB;
constexpr size_t R2_KVMLA = 48 * MiB, R2_OB = 64 * MiB, R2_HALO = 64 * MiB, R2_PART = 76 * MiB, R2_VAL = 88 * MiB;
constexpr size_t OW_EIN = 0;
constexpr size_t OW_EUQ = OW_EIN + 2ull * EIN_NP * 1024;
constexpr size_t OW_EUKV = OW_EUQ + 2ull * 768 * 384;
constexpr size_t OW_EOUT = OW_EUKV + 2ull * 1024 * 256;
constexpr size_t OW_OIN = OW_EOUT + 2ull * 1024 * 1024;
constexpr size_t OW_OOUT = OW_OIN + 2ull * OIN_N * 1024;
constexpr size_t OW_UP = OW_OOUT + 2ull * 1024 * 1024;
constexpr size_t OW_DN = OW_UP + 4ull * 5632 * 1024;
constexpr size_t OW_END = OW_DN + 4ull * 1024 * D_FF;
static_assert(WS_W + OW_END * 2 <= WS_HN, "weights fit");

constexpr int LDS_BYTES = 135168;
constexpr int NTHREADS = 512, NWAVES = 8;

__device__ __forceinline__ unsigned cvt_pk_bf16(float lo, float hi) { unsigned r; asm volatile("v_cvt_pk_bf16_f32 %0, %1, %2" : "=v"(r) : "v"(lo), "v"(hi)); return r; }
__device__ __forceinline__ float bf_lo(unsigned w) { return __uint_as_float(w << 16); }
__device__ __forceinline__ float bf_hi(unsigned w) { return __uint_as_float(w & 0xffff0000u); }
__device__ __forceinline__ float bf2f(bf16_t v) { return __uint_as_float(((unsigned)v) << 16); }
__device__ __forceinline__ float shflx(float v, int m, int lane) { return __int_as_float(__builtin_amdgcn_ds_bpermute((lane ^ m) << 2, __float_as_int(v))); }
__device__ __forceinline__ float wave_sum(float v, int lane) {
#pragma unroll
    for (int o = 1; o < 64; o <<= 1) v += shflx(v, o, lane);
    return v;
}
__device__ __forceinline__ float gelu_tanh(float x) {
    const float u = 0.7978845608028654f * (x + 0.044715f * x * x * x);
    const float e = __builtin_amdgcn_exp2f(-2.0f * LOG2E * u);
    return x * __builtin_amdgcn_rcpf(1.0f + e);
}

namespace pg8 {
constexpr int BM = 256, BK = 64, HALF = 128, HTB = HALF * BK * 2, STAGE_BYTES = 8 * HTB, NXCD = 8, WGM = 8;
__host__ __device__ __forceinline__ int lds_byte(int r, int c) { const int st = (r >> 4) * 2 + (c >> 5), rr = r & 15, cc = c & 31, ob = rr * 64 + cc * 2; return st * 1024 + (ob ^ (((ob >> 9) & 1) << 5)); }
__host__ __device__ __forceinline__ void stage_rc(int b, int& R, int& C) { const int st = b / 1024, sb = b % 1024, swz = sb ^ (((sb >> 9) & 1) << 5); R = (st >> 1) * 16 + swz / 64; C = (st & 1) * 32 + (swz % 64) / 2; }
__host__ __device__ __forceinline__ int perm32(int rho) { const int n = rho >> 4, i = rho & 15; return 8 * (i >> 2) + 4 * n + (i & 3); }

struct Unit { int pm, pn; };
struct Gemm { const bf16_t* A; const bf16_t* Bt; int M, N, K, lda, ldb; };

struct StaticOrder {
    int nM, nN, nwg, G, c;
    __host__ __device__ void init(int M, int N, int G_, int c_) { nM = M / BM; nN = N / BM; nwg = nM * nN; G = G_; c = c_; }
    __host__ __device__ bool next(int i, Unit& u) const {
        const long L = (long)i * G + c; if (L >= nwg) return false;
        int wgid = (int)L; { const int q = nwg / NXCD, r = nwg % NXCD, xcd = wgid % NXCD, off = wgid / NXCD; wgid = (xcd < r ? xcd * (q + 1) : r * (q + 1) + (xcd - r) * q) + off; }
        const int nig = WGM * nN, gid = wgid / nig, fm = gid * WGM, gsz = (nM - fm) < WGM ? (nM - fm) : WGM;
        u.pm = fm + ((wgid % nig) % gsz); u.pn = (wgid % nig) / gsz; return true;
    }
};

template <class Epi, class Sched, bool ALIGN_EPI>
__device__ __forceinline__ void gemm_phase(LAS unsigned char* lds, const Gemm g, const Sched& S, const Epi& E, const int tid) {
    const int wid = __builtin_amdgcn_readfirstlane(tid >> 6), lane = tid & 63, wr = wid >> 2, wc = wid & 3, fr = lane & 15, fq = lane >> 4;
    const int K = g.K, nt = K / BK;
    unsigned voffA[2], voffB[2];
#pragma unroll
    for (int i = 0; i < 2; ++i) { int R, C; stage_rc(tid * 16 + i * 8192, R, C); const int Rb = (R & ~31) + perm32(R & 31);
        voffA[i] = (unsigned)(R * g.lda + C) * 2u; voffB[i] = (unsigned)(Rb * g.ldb + C) * 2u; }
    const size_t kstep = (size_t)(BK * 2);
    const size_t hstepA = (size_t)HALF * g.lda * 2, hstepB = (size_t)HALF * g.ldb * 2;
    const size_t tstepA = 2 * hstepA, tstepB = 2 * hstepB;
    const unsigned ldsw = (unsigned)wid * 1024u;
    const int aoff = lds_byte(wr * 64 + fr, fq * 8), boff = lds_byte(wc * 32 + fr, fq * 8);
#define PG8_SA(b, h) (((b) * 2 + (h)) * HTB)
#define PG8_SB(b, h) ((4 + (b) * 2 + (h)) * HTB)
#define PG8_STAGE(bufoff, gbase, voff) do { _Pragma("unroll") for (int _i = 0; _i < 2; ++_i) \
        __builtin_amdgcn_global_load_lds((const unsigned*)((const char*)(gbase) + (voff)[_i]), (LAS unsigned*)(lds + (bufoff) + ldsw + _i * 8192), 16, 0, 0); } while (0)
#define PG8_LDA(dst, b, h) do { _Pragma("unroll") for (int m = 0; m < 4; ++m) _Pragma("unroll") for (int k = 0; k < 2; ++k) dst[m][k] = *(const LAS bf16x8*)(lds + PG8_SA(b, h) + aoff + m * 2048 + k * 1024); } while (0)
#define PG8_LDB(dst, b, h) do { _Pragma("unroll") for (int n = 0; n < 2; ++n) _Pragma("unroll") for (int k = 0; k < 2; ++k) dst[n][k] = *(const LAS bf16x8*)(lds + PG8_SB(b, h) + boff + n * 2048 + k * 1024); } while (0)
#define PG8_MMA(ai, bj, At, Bt) do { __builtin_amdgcn_s_setprio(1); _Pragma("unroll") for (int m = 0; m < 4; ++m) _Pragma("unroll") for (int n = 0; n < 2; ++n) _Pragma("unroll") for (int k = 0; k < 2; ++k) \
        acc[ai][bj][m][n] = __builtin_amdgcn_mfma_f32_16x16x32_bf16(Bt[n][k], At[m][k], acc[ai][bj][m][n], 0, 0, 0); __builtin_amdgcn_s_setprio(0); } while (0)
#define PG8_WAIT_V(n) asm volatile("s_waitcnt vmcnt(" #n ")" ::: "memory")
#define PG8_WAIT_L(n) asm volatile("s_waitcnt lgkmcnt(" #n ")" ::: "memory")
#define PG8_BAR __builtin_amdgcn_s_barrier()
#define PG8_SCHED __builtin_amdgcn_sched_barrier(0)
    Unit cur, nxt; int ui = 0;
    if (!S.next(0, cur)) return;
    f32x4 acc[2][2][4][2];
#pragma unroll
    for (int a = 0; a < 2; ++a)
#pragma unroll
        for (int b = 0; b < 2; ++b)
#pragma unroll
            for (int m = 0; m < 4; ++m)
#pragma unroll
                for (int n = 0; n < 2; ++n) acc[a][b][m][n] = (f32x4){0.f, 0.f, 0.f, 0.f};
    bf16x8 At[4][2], B0[2][2], B1[2][2];
    const char* cA = (const char*)g.A + (size_t)cur.pm * tstepA; const char* cB = (const char*)g.Bt + (size_t)cur.pn * tstepB;
    PG8_STAGE(PG8_SB(0, 0), cB, voffB); PG8_STAGE(PG8_SB(0, 1), cB + hstepB, voffB); PG8_STAGE(PG8_SA(0, 0), cA, voffA); PG8_STAGE(PG8_SA(0, 1), cA + hstepA, voffA);
    if (wr == 1) PG8_BAR;
    PG8_WAIT_V(2); PG8_BAR;
    PG8_STAGE(PG8_SB(1, 0), cB + kstep, voffB); PG8_STAGE(PG8_SA(1, 0), cA + kstep, voffA); PG8_STAGE(PG8_SB(1, 1), cB + hstepB + kstep, voffB);
    PG8_WAIT_V(6); PG8_BAR;
    for (;;) {
        const bool has_next = S.next(ui + 1, nxt);
        const char* nA = has_next ? (const char*)g.A + (size_t)nxt.pm * tstepA : cA; const char* nB = has_next ? (const char*)g.Bt + (size_t)nxt.pn * tstepB : cB;
        for (int t = 0; t < nt; t += 2) {
            const bool last = (t == nt - 2);
            const char* a1 = cA + (size_t)(t + 1) * kstep;
            const char* a2 = last ? nA : cA + (size_t)(t + 2) * kstep; const char* b2 = last ? nB : cB + (size_t)(t + 2) * kstep;
            const char* a3 = a2 + kstep; const char* b3 = b2 + kstep;
            PG8_LDB(B0, 0, 0); PG8_LDB(B1, 0, 1); PG8_SCHED; PG8_LDA(At, 0, 0); PG8_STAGE(PG8_SA(1, 1), a1 + hstepA, voffA);
            PG8_WAIT_V(8); PG8_WAIT_L(0); PG8_BAR; PG8_MMA(0, 0, At, B0); PG8_MMA(0, 1, At, B1); PG8_BAR; PG8_SCHED;
            PG8_LDA(At, 0, 1); PG8_STAGE(PG8_SB(0, 0), b2, voffB); PG8_STAGE(PG8_SB(0, 1), b2 + hstepB, voffB); PG8_STAGE(PG8_SA(0, 0), a2, voffA);
            PG8_WAIT_V(8); PG8_WAIT_L(0); PG8_BAR; PG8_MMA(1, 0, At, B0); PG8_MMA(1, 1, At, B1); PG8_BAR; PG8_SCHED;
            PG8_LDB(B0, 1, 0); PG8_LDB(B1, 1, 1); PG8_SCHED; PG8_LDA(At, 1, 0); PG8_STAGE(PG8_SA(0, 1), a2 + hstepA, voffA);
            PG8_WAIT_V(8); PG8_WAIT_L(0); PG8_BAR; PG8_MMA(0, 0, At, B0); PG8_MMA(0, 1, At, B1); PG8_BAR; PG8_SCHED;
            PG8_LDA(At, 1, 1); PG8_STAGE(PG8_SB(1, 0), b3, voffB); PG8_STAGE(PG8_SB(1, 1), b3 + hstepB, voffB); PG8_STAGE(PG8_SA(1, 0), a3, voffA);
            PG8_WAIT_V(8); PG8_WAIT_L(0); PG8_BAR; PG8_MMA(1, 0, At, B0); PG8_MMA(1, 1, At, B1); PG8_BAR; PG8_SCHED;
        }
        if constexpr (ALIGN_EPI) { if (wr == 0) PG8_BAR; }
        E(acc, cur, wr, wc, fr, fq);
        if (!has_next) break;
#pragma unroll
        for (int a = 0; a < 2; ++a)
#pragma unroll
            for (int b = 0; b < 2; ++b)
#pragma unroll
                for (int m = 0; m < 4; ++m)
#pragma unroll
                    for (int n = 0; n < 2; ++n) acc[a][b][m][n] = (f32x4){0.f, 0.f, 0.f, 0.f};
        cur = nxt; cA = nA; cB = nB; ++ui;
        if constexpr (ALIGN_EPI) { if (wr == 1) PG8_BAR; }
    }
    PG8_WAIT_V(0);
    if constexpr (!ALIGN_EPI) { if (wr == 0) PG8_BAR; }
    PG8_BAR;
#undef PG8_SA
#undef PG8_SB
#undef PG8_STAGE
#undef PG8_LDA
#undef PG8_LDB
#undef PG8_MMA
#undef PG8_WAIT_V
#undef PG8_WAIT_L
#undef PG8_BAR
#undef PG8_SCHED
}
}

struct EpiStore {
    bf16_t* O; int ldc; int scale_cols; float s0; const float* rowscale; float rs_mul; const float* ropec; const float* ropes;
    __device__ __forceinline__ void operator()(const f32x4 (&acc)[2][2][4][2], const pg8::Unit& u, int wr, int wc, int fr, int fq) const {
        const int row0 = u.pm * 256 + wr * 64 + fr;
#pragma unroll
        for (int bj = 0; bj < 2; ++bj) {
            const int colg = u.pn * 256 + bj * 128 + wc * 32, col0 = colg + 8 * fq;
            const float sc = (colg < scale_cols) ? s0 : 1.0f;
            const bool rope = (ropec != nullptr) && (((colg >> 5) % 3) == 2);
#pragma unroll
            for (int ai = 0; ai < 2; ++ai)
#pragma unroll
                for (int m = 0; m < 4; ++m) {
                    const int row = row0 + ai * 128 + m * 16;
                    float f = sc; if (rowscale) f *= rowscale[row] * rs_mul;
                    f32x4 v0 = acc[ai][bj][m][0] * f, v1 = acc[ai][bj][m][1] * f;
                    if (rope) {
                        const int pos = row & (SEQ - 1), i0 = (8 * fq) & 15;
                        const f32x4 c0 = *(const f32x4*)(ropec + pos * 16 + i0), c1 = *(const f32x4*)(ropec + pos * 16 + i0 + 4);
                        const f32x4 s0v = *(const f32x4*)(ropes + pos * 16 + i0), s1v = *(const f32x4*)(ropes + pos * 16 + i0 + 4);
                        f32x4 p0, p1;
#pragma unroll
                        for (int e = 0; e < 4; ++e) { p0[e] = shflx(v0[e], 32, fq * 16 + fr); p1[e] = shflx(v1[e], 32, fq * 16 + fr); }
                        if (fq < 2) { v0 = v0 * c0 - p0 * s0v; v1 = v1 * c1 - p1 * s1v; }
                        else { v0 = p0 * s0v + v0 * c0; v1 = p1 * s1v + v1 * c1; }
                    }
                    u32x4 w; w.x = cvt_pk_bf16(v0[0], v0[1]); w.y = cvt_pk_bf16(v0[2], v0[3]); w.z = cvt_pk_bf16(v1[0], v1[1]); w.w = cvt_pk_bf16(v1[2], v1[3]);
                    *(u32x4*)(O + (size_t)row * ldc + col0) = w;
                }
        }
    }
};

__device__ __forceinline__ float dpp_ror1(float v) { return __int_as_float(__builtin_amdgcn_update_dpp(0, __float_as_int(v), 0x121, 0xf, 0xf, false)); }
__device__ __forceinline__ float dpp_ror2(float v) { return __int_as_float(__builtin_amdgcn_update_dpp(0, __float_as_int(v), 0x122, 0xf, 0xf, false)); }

struct EpiConv {
    bf16_t* act; const float* cw; const float* cb; float* halo; float* part; float* val01;
    __device__ __forceinline__ void operator()(const f32x4 (&acc)[2][2][4][2], const pg8::Unit& u, int wr, int wc, int fr, int fq) const {
        const int colb = u.pn * 128 + wc * 32 + 8 * fq;
        f32x4 w0[2], w1[2], w2[2], bb[2];
#pragma unroll
        for (int n = 0; n < 2; ++n) { const int col = colb + 4 * n;
            w0[n] = *(const f32x4*)(cw + col); w1[n] = *(const f32x4*)(cw + D_FF + col); w2[n] = *(const f32x4*)(cw + 2 * D_FF + col); bb[n] = *(const f32x4*)(cb + col); }
#pragma unroll
        for (int ai = 0; ai < 2; ++ai) {
            const int chunk = u.pm * 4 + ai * 2 + wr;
            f32x4 gprev[2]; gprev[0] = (f32x4){0.f, 0.f, 0.f, 0.f}; gprev[1] = gprev[0];
#pragma unroll
            for (int m = 0; m < 4; ++m) {
                const int row = u.pm * 256 + ai * 128 + wr * 64 + m * 16 + fr;
                u32x4 wq;
#pragma unroll
                for (int n = 0; n < 2; ++n) {
                    const int col = colb + 4 * n;
                    const f32x4 g = acc[ai][0][m][n], v = acc[ai][1][m][n];
                    f32x4 cv, o;
#pragma unroll
                    for (int e = 0; e < 4; ++e) {
                        const float h1 = (fr == 15) ? gprev[n][e] : g[e], h2 = (fr >= 14) ? gprev[n][e] : g[e];
                        const float p1 = dpp_ror1(h1), p2 = dpp_ror2(h2);
                        cv[e] = bb[n][e] + w2[n][e] * g[e] + w1[n][e] * p1 + w0[n][e] * p2;
                        const float x = cv[e], t = x * x * (-0.10294324f) + (-2.302208198f);
                        const float ex = __builtin_amdgcn_exp2f(x * t);
                        o[e] = (x * v[e]) * __builtin_amdgcn_rcpf(1.0f + ex);
                    }
                    if (m == 0 && fr < 2) { *(f32x4*)(part + (size_t)(chunk * 2 + fr) * D_FF + col) = cv; *(f32x4*)(val01 + (size_t)(chunk * 2 + fr) * D_FF + col) = v; }
                    if (m == 3 && fr >= 14) { *(f32x4*)(halo + (size_t)(chunk * 2 + fr - 14) * D_FF + col) = g; }
                    if (n == 0) { wq.x = cvt_pk_bf16(o[0], o[1]); wq.y = cvt_pk_bf16(o[2], o[3]); } else { wq.z = cvt_pk_bf16(o[0], o[1]); wq.w = cvt_pk_bf16(o[2], o[3]); }
                    gprev[n] = g;
                }
                *(u32x4*)(act + (size_t)row * D_FF + colb) = wq;
            }
        }
    }
};

struct AttnP {
    const bf16_t* Q; int ldq;
    const bf16_t* K1; int ldk1;
    const bf16_t* K2;
    const bf16_t* V; int ldv;
    bf16_t* O; int ldo;
    const float* bias;
    float sl2;
    const bf16_t* Oprev;
    const float* subln; float lam, osc;
};


__device__ __forceinline__ float max3f(float a, float b, float c) { float r; asm("v_max3_f32 %0, %1, %2, %3" : "=v"(r) : "v"(a), "v"(b), "v"(c)); return r; }
__device__ __forceinline__ float fadd_s(float a, float b) { float r; asm("v_add_f32_e32 %0, %1, %2" : "=v"(r) : "v"(a), "v"(b)); return r; }
__device__ __forceinline__ float fsub_s(float a, float b) { float r; asm("v_sub_f32_e32 %0, %1, %2" : "=v"(r) : "v"(a), "v"(b)); return r; }
__device__ __forceinline__ int crow(int r, int hi) { return (r & 3) + 8 * (r >> 2) + 4 * hi; }

template <int DQK, int DV, int MODE>
__device__ __forceinline__ void attn_unit(LAS unsigned char* lds, const AttnP& P, size_t rowbase, int qb, const int tid, const int pm) {
    constexpr int KST = DQK * 2 + 16, VST = (DV == 64) ? 192 : 320;
    constexpr int KBYTES = 64 * KST, VBYTES = 64 * VST, BUF = KBYTES + VBYTES + 256;
    constexpr int NKS = DQK / 16, NDB = DV / 32;
    const int lane = tid & 63, wid = __builtin_amdgcn_readfirstlane(tid >> 6), r32 = lane & 31, hi = lane >> 5;
    const int q0 = qb * 256, NT = 4 * qb + 4, ktlast = 4 * qb + (wid >> 1);
    const int qpos = q0 + wid * 32 + r32;
    bf16x8 qf[NKS];
    {
        const bf16_t* qrow = P.Q + (rowbase + qpos) * (size_t)P.ldq + hi * 8;
#pragma unroll
        for (int ks = 0; ks < NKS; ++ks) qf[ks] = *(const bf16x8*)(qrow + ks * 16);
    }
    float cq2 = 0.f;
    if (MODE == 0) cq2 = P.bias[qpos];
    float sdiag = 0.f;
    {
        const bf16_t* kd = P.K1 + (rowbase + qpos) * (size_t)P.ldk1 + hi * 8;
#pragma unroll
        for (int ks = 0; ks < NKS; ++ks) {
            const u32x4 kv_ = (MODE == 1 && ks >= 4) ? *(const u32x4*)(P.K2 + (rowbase + qpos) * 32 + (ks - 4) * 16 + hi * 8) : *(const u32x4*)(kd + ks * 16);
            const u32x4 qv_ = __builtin_bit_cast(u32x4, qf[ks]);
            sdiag += bf_lo(qv_.x) * bf_lo(kv_.x) + bf_hi(qv_.x) * bf_hi(kv_.x) + bf_lo(qv_.y) * bf_lo(kv_.y) + bf_hi(qv_.y) * bf_hi(kv_.y)
                   + bf_lo(qv_.z) * bf_lo(kv_.z) + bf_hi(qv_.z) * bf_hi(kv_.z) + bf_lo(qv_.w) * bf_lo(kv_.w) + bf_hi(qv_.w) * bf_hi(kv_.w);
        }
        auto rr_ = __builtin_amdgcn_permlane32_swap(__float_as_uint(sdiag), __float_as_uint(sdiag), false, false);
        sdiag = __uint_as_float(rr_[0]) + __uint_as_float(rr_[1]);
    }
    u32x4 kA0, kA1, vA0, vA1, kB0, kB1, vB0, vB1; float bA = 0.f, bB = 0.f;
    kA1 = (u32x4){0, 0, 0, 0}; vA1 = kA1; kB1 = kA1; vB1 = kA1;
    const int krow = tid >> 3, kch = tid & 7, k2row = tid >> 2, k2ch = tid & 3;
    const int vrow = (DV == 64) ? (tid >> 3) : (tid >> 4), vch = (DV == 64) ? (tid & 7) : (tid & 15);
    const unsigned koff = (unsigned)(krow * P.ldk1 + kch * 8), k2off = (unsigned)(k2row * 32 + k2ch * 8), voff0 = (unsigned)(vrow * P.ldv + vch * 8), voff1 = voff0 + 32u * (unsigned)P.ldv;
#define ATT_LOAD(X, kt) do { const size_t tr0 = rowbase + (size_t)(kt) * 64; \
        const bf16_t* kb_u = P.K1 + tr0 * P.ldk1; const bf16_t* vb_u = P.V + tr0 * P.ldv; \
        k##X##0 = *(const u32x4*)(kb_u + koff); \
        if (MODE == 1) { const bf16_t* k2_u = P.K2 + tr0 * 32; if (tid < 256) k##X##1 = *(const u32x4*)(k2_u + k2off); } \
        v##X##0 = *(const u32x4*)(vb_u + voff0); \
        if (DV == 128) v##X##1 = *(const u32x4*)(vb_u + voff1); \
        if (MODE == 0) { const float* b_u = P.bias + (kt) * 64; if (tid < 64) b##X = b_u[(unsigned)tid]; } } while (0)
#define ATT_STORE(X, buf) do { LAS unsigned char* bb_ = lds + (buf) * BUF; \
        *(LAS u32x4*)(bb_ + krow * KST + kch * 16) = k##X##0; \
        if (MODE == 1) { if (tid < 256) *(LAS u32x4*)(bb_ + k2row * KST + (8 + k2ch) * 16) = k##X##1; } \
        *(LAS u32x4*)(bb_ + KBYTES + vrow * VST + vch * 16) = v##X##0; \
        if (DV == 128) *(LAS u32x4*)(bb_ + KBYTES + (vrow + 32) * VST + vch * 16) = v##X##1; \
        if (MODE == 0) { if (tid < 64) *(LAS float*)(bb_ + KBYTES + VBYTES + tid * 4) = b##X; } } while (0)

    f32x16 o[NDB];
#pragma unroll
    for (int db = 0; db < NDB; ++db)
#pragma unroll
        for (int r = 0; r < 16; ++r) o[db][r] = 0.f;
    float mref = sdiag, lrun = 0.f;

    bf16x8 kf[2 * NKS];
#define ATT_READV(dst, db) do { _Pragma("unroll") for (int s_ = 0; s_ < 4; ++s_) { \
        const s16x4 t1 = __builtin_amdgcn_ds_read_tr16_b64_v4i16((LAS s16x4*)(vlane + (16 * s_) * VST + (db) * 64)); \
        const s16x4 t2 = __builtin_amdgcn_ds_read_tr16_b64_v4i16((LAS s16x4*)(vlane + (16 * s_ + 8) * VST + (db) * 64)); \
        dst[s_] = (bf16x8){t1[0], t1[1], t1[2], t1[3], t2[0], t2[1], t2[2], t2[3]}; } } while (0)
#define ATT_COMPUTE(kt, cb, RDK, PFK) do { \
            LAS unsigned char* kb = lds + (cb) * BUF; \
            LAS unsigned char* vb = kb + KBYTES; \
            bf16x8 kfl_[2 * NKS]; bf16x8 (&kfr)[2 * NKS] = *((MODE == 0) ? &kf : &kfl_); \
            f32x16 s0, s1; \
            if (MODE == 0) { \
                LAS unsigned char* bp = vb + VBYTES; const float cqm = cq2 - mref; \
                _Pragma("unroll") for (int a = 0; a < 4; ++a) { \
                    const f32x4 c0 = *(LAS f32x4*)(bp + (8 * a + 4 * hi) * 4), c1 = *(LAS f32x4*)(bp + (32 + 8 * a + 4 * hi) * 4); \
                    _Pragma("unroll") for (int e = 0; e < 4; ++e) { s0[4 * a + e] = fsub_s(cqm, c0[e]); s1[4 * a + e] = fsub_s(cqm, c1[e]); } } \
            } else if (MODE == 2) { \
                const float c0 = P.sl2 * (float)((kt) * 64 + 4 * hi - qpos) - mref; \
                const float c32 = 32.0f * P.sl2; _Pragma("unroll") for (int r = 0; r < 16; ++r) { s0[r] = fadd_s(c0, P.sl2 * (float)((r & 3) + 8 * (r >> 2))); s1[r] = fadd_s(s0[r], c32); } \
            } else { \
                _Pragma("unroll") for (int r = 0; r < 16; ++r) { s0[r] = -mref; s1[r] = -mref; } \
            } \
            { if (RDK) { _Pragma("unroll") for (int ks = 0; ks < NKS; ++ks) { \
                kfr[2 * ks] = *(LAS bf16x8*)(kb + r32 * KST + ks * 32 + hi * 16); \
                kfr[2 * ks + 1] = *(LAS bf16x8*)(kb + (r32 + 32) * KST + ks * 32 + hi * 16); } } \
              if (DV == 64) __builtin_amdgcn_sched_barrier(0); \
              __builtin_amdgcn_s_setprio(1); \
              _Pragma("unroll") for (int ks = 0; ks < NKS; ++ks) { \
                s0 = __builtin_amdgcn_mfma_f32_32x32x16_bf16(kfr[2 * ks], qf[ks], s0, 0, 0, 0); \
                s1 = __builtin_amdgcn_mfma_f32_32x32x16_bf16(kfr[2 * ks + 1], qf[ks], s1, 0, 0, 0); } \
              __builtin_amdgcn_s_setprio(0); \
              if (PFK) { LAS unsigned char* kn_ = kb + BUF; _Pragma("unroll") for (int ks = 0; ks < NKS; ++ks) { \
                kfr[2 * ks] = *(LAS bf16x8*)(kn_ + r32 * KST + ks * 32 + hi * 16); \
                kfr[2 * ks + 1] = *(LAS bf16x8*)(kn_ + (r32 + 32) * KST + ks * 32 + hi * 16); } } } \
            LAS unsigned char* vlane = vb + (4 * hi + ((lane & 15) >> 2)) * VST + (16 * ((lane >> 4) & 1) + 4 * (lane & 3)) * 2; \
            bf16x8 vf[2][4]; \
            { ATT_READV(vf[0], 0); } \
            __builtin_amdgcn_sched_barrier(0); \
            if ((kt) == ktlast) { \
                const int kbase = (kt) * 64 + 4 * hi; \
                _Pragma("unroll") for (int r = 0; r < 16; ++r) { const int key = kbase + (r & 3) + 8 * (r >> 2); if (key > qpos) s0[r] = NEGBIG; if (key + 32 > qpos) s1[r] = NEGBIG; } } \
            float mx = max3f(s0[0], s1[0], s0[1]), mx2 = max3f(s1[1], s0[2], s1[2]); \
            _Pragma("unroll") for (int r = 3; r < 15; r += 2) { mx = max3f(mx, s0[r], s1[r]); mx2 = max3f(mx2, s0[r + 1], s1[r + 1]); } \
            mx = max3f(mx, s0[15], s1[15]); mx = max3f(mx, mx2, mx2); \
            { auto rr_ = __builtin_amdgcn_permlane32_swap(__float_as_uint(mx), __float_as_uint(mx), false, false); mx = fmaxf(__uint_as_float(rr_[0]), __uint_as_float(rr_[1])); } \
            if (__any(mx > 64.0f)) { \
                const float dl = fmaxf(mx, 0.f); \
                const float alpha = __builtin_amdgcn_exp2f(-dl); \
                mref += dl; lrun *= alpha; \
                _Pragma("unroll") for (int r = 0; r < 16; ++r) { s0[r] -= dl; s1[r] -= dl; } \
                _Pragma("unroll") for (int db = 0; db < NDB; ++db) _Pragma("unroll") for (int r = 0; r < 16; ++r) o[db][r] *= alpha; } \
            float ls = 0.f, ls2 = 0.f; \
            _Pragma("unroll") for (int r = 0; r < 16; ++r) { s0[r] = __builtin_amdgcn_exp2f(s0[r]); s1[r] = __builtin_amdgcn_exp2f(s1[r]); ls = fadd_s(ls, s0[r]); ls2 = fadd_s(ls2, s1[r]); } \
            lrun += fadd_s(ls, ls2); \
            u32x4 pw[4]; \
            pw[0] = (u32x4){cvt_pk_bf16(s0[0], s0[1]), cvt_pk_bf16(s0[2], s0[3]), cvt_pk_bf16(s0[4], s0[5]), cvt_pk_bf16(s0[6], s0[7])}; \
            pw[1] = (u32x4){cvt_pk_bf16(s0[8], s0[9]), cvt_pk_bf16(s0[10], s0[11]), cvt_pk_bf16(s0[12], s0[13]), cvt_pk_bf16(s0[14], s0[15])}; \
            pw[2] = (u32x4){cvt_pk_bf16(s1[0], s1[1]), cvt_pk_bf16(s1[2], s1[3]), cvt_pk_bf16(s1[4], s1[5]), cvt_pk_bf16(s1[6], s1[7])}; \
            pw[3] = (u32x4){cvt_pk_bf16(s1[8], s1[9]), cvt_pk_bf16(s1[10], s1[11]), cvt_pk_bf16(s1[12], s1[13]), cvt_pk_bf16(s1[14], s1[15])}; \
            \
            _Pragma("unroll") for (int db = 0; db < NDB; ++db) { \
                if (db + 1 < NDB) ATT_READV(vf[(db + 1) & 1], db + 1); \
                __builtin_amdgcn_sched_barrier(0); \
                __builtin_amdgcn_s_setprio(1); \
                _Pragma("unroll") for (int s = 0; s < 4; ++s) \
                    o[db] = __builtin_amdgcn_mfma_f32_32x32x16_bf16(vf[db & 1][s], __builtin_bit_cast(bf16x8, pw[s]), o[db], 0, 0, 0); \
                __builtin_amdgcn_s_setprio(0); \
                __builtin_amdgcn_sched_barrier(0); } \
        } while (0)

#define ATT_BAR() do { asm volatile("s_waitcnt lgkmcnt(0)" ::: "memory"); __builtin_amdgcn_s_barrier(); asm volatile("" ::: "memory"); } while (0)
    ATT_LOAD(A, 0); ATT_LOAD(B, 1);
    ATT_STORE(A, 0); ATT_STORE(B, 1);
    ATT_LOAD(A, 2); ATT_LOAD(B, 3);
    ATT_BAR();
    for (int kt = 0; kt < NT; kt += 2) {
        const int sb = (kt & 2);
        const bool two_ = (kt + 1 <= ktlast);
        if (kt <= ktlast && pm != 1) ATT_COMPUTE(kt, sb, true, (KPF2 && MODE == 0 && two_));
        if (two_ && pm != 1) ATT_COMPUTE(kt + 1, sb + 1, !(KPF2 && MODE == 0), false);
        if (kt + 2 < NT && pm < 2) { ATT_STORE(A, sb ^ 2); ATT_STORE(B, (sb ^ 2) + 1); }
        if (pm != 3) ATT_BAR();
        if (kt + 4 < NT && pm < 2) { ATT_LOAD(A, kt + 4); ATT_LOAD(B, kt + 5); }
    }
    ATT_BAR();
    float ltot; { auto rr_ = __builtin_amdgcn_permlane32_swap(__float_as_uint(lrun), __float_as_uint(lrun), false, false); ltot = __uint_as_float(rr_[0]) + __uint_as_float(rr_[1]); }
    const float inv = 1.0f / ltot;
    int qpe_ = qpos; asm volatile("" : "+v"(qpe_));
    bf16_t* orow = P.O + (rowbase + qpe_) * (size_t)P.ldo + 8 * hi;
    if (MODE == 2 && P.Oprev != nullptr) {
        const bf16_t* prow = P.Oprev + (rowbase + qpe_) * (size_t)P.ldo + 8 * hi;
        f32x4 cv[NDB][2][2]; float ss = 0.f;
#pragma unroll
        for (int db = 0; db < NDB; ++db)
#pragma unroll
            for (int a = 0; a < 4; a += 2) {
                const unsigned x0 = cvt_pk_bf16(o[db][4 * a] * inv, o[db][4 * a + 1] * inv), x1 = cvt_pk_bf16(o[db][4 * a + 2] * inv, o[db][4 * a + 3] * inv);
                const unsigned y0 = cvt_pk_bf16(o[db][4 * a + 4] * inv, o[db][4 * a + 5] * inv), y1 = cvt_pk_bf16(o[db][4 * a + 6] * inv, o[db][4 * a + 7] * inv);
                const auto s0_ = __builtin_amdgcn_permlane32_swap(x0, y0, false, false);
                const auto s1_ = __builtin_amdgcn_permlane32_swap(x1, y1, false, false);
                const u32x4 w1 = *(const u32x4*)(prow + db * 32 + a * 8);
                const f32x4 d0 = (f32x4){bf_lo(w1.x) - P.lam * bf_lo(s0_[0]), bf_hi(w1.x) - P.lam * bf_hi(s0_[0]), bf_lo(w1.y) - P.lam * bf_lo(s1_[0]), bf_hi(w1.y) - P.lam * bf_hi(s1_[0])};
                const f32x4 d1 = (f32x4){bf_lo(w1.z) - P.lam * bf_lo(s0_[1]), bf_hi(w1.z) - P.lam * bf_hi(s0_[1]), bf_lo(w1.w) - P.lam * bf_lo(s1_[1]), bf_hi(w1.w) - P.lam * bf_hi(s1_[1])};
                cv[db][a >> 1][0] = d0; cv[db][a >> 1][1] = d1;
                ss += (d0[0] * d0[0] + d0[1] * d0[1]) + (d0[2] * d0[2] + d0[3] * d0[3]) + (d1[0] * d1[0] + d1[1] * d1[1]) + (d1[2] * d1[2] + d1[3] * d1[3]);
            }
        { auto rr_ = __builtin_amdgcn_permlane32_swap(__float_as_uint(ss), __float_as_uint(ss), false, false); ss = __uint_as_float(rr_[0]) + __uint_as_float(rr_[1]); }
        const float rs = rsqrtf(ss * (1.0f / 128.0f) + RMS_EPS) * P.osc;
        const float* sgp = P.subln + 8 * hi;
#pragma unroll
        for (int db = 0; db < NDB; ++db)
#pragma unroll
            for (int a = 0; a < 4; a += 2) {
                const f32x4 g0 = *(const f32x4*)(sgp + db * 32 + a * 8), g1 = *(const f32x4*)(sgp + db * 32 + a * 8 + 4);
                const f32x4 e0 = cv[db][a >> 1][0] * rs * g0, e1 = cv[db][a >> 1][1] * rs * g1;
                u32x4 w; w.x = cvt_pk_bf16(e0[0], e0[1]); w.y = cvt_pk_bf16(e0[2], e0[3]); w.z = cvt_pk_bf16(e1[0], e1[1]); w.w = cvt_pk_bf16(e1[2], e1[3]);
                *(u32x4*)(orow + db * 32 + a * 8) = w;
            }
    } else {
#pragma unroll
    for (int db = 0; db < NDB; ++db)
#pragma unroll
        for (int a = 0; a < 4; a += 2) {
            const unsigned x0 = cvt_pk_bf16(o[db][4 * a] * inv, o[db][4 * a + 1] * inv), x1 = cvt_pk_bf16(o[db][4 * a + 2] * inv, o[db][4 * a + 3] * inv);
            const unsigned y0 = cvt_pk_bf16(o[db][4 * a + 4] * inv, o[db][4 * a + 5] * inv), y1 = cvt_pk_bf16(o[db][4 * a + 6] * inv, o[db][4 * a + 7] * inv);
            const auto s0_ = __builtin_amdgcn_permlane32_swap(x0, y0, false, false);
            const auto s1_ = __builtin_amdgcn_permlane32_swap(x1, y1, false, false);
            u32x4 w; w.x = s0_[0]; w.y = s1_[0]; w.z = s0_[1]; w.w = s1_[1];
            *(u32x4*)(orow + db * 32 + a * 8) = w;
        }
    }
#undef ATT_COMPUTE
#undef ATT_READV
#undef ATT_BAR
#undef ATT_LOAD
#undef ATT_STORE
}


#define XB_TMO      128
#define XB_XCNT(j)  (256  + 64 * (j))
#define XB_XSUB(j)  (1280 + 64 * (j))
#define XB_XGEN(j)  (2304 + 64 * (j))
#define XB_TOP      3328
#define XB_TOPGEN   3392
#define XCD_BAR_WORDS 3456
#define XB_SPIN_CAP (1u << 18)

__device__ __forceinline__ unsigned xb_ld(unsigned* p)              { return __hip_atomic_load(p, __ATOMIC_RELAXED, __HIP_MEMORY_SCOPE_AGENT); }
__device__ __forceinline__ unsigned xb_add(unsigned* p, unsigned v) { return __hip_atomic_fetch_add(p, v, __ATOMIC_RELAXED, __HIP_MEMORY_SCOPE_AGENT); }
__device__ __forceinline__ unsigned xb_xcc_id() { return (unsigned)__builtin_amdgcn_s_getreg((3 << 11) | 20) & 0xFu; }
#define XB_SPIN(cond, bar) do { unsigned _sp = 0; while (cond) { __builtin_amdgcn_s_sleep(1); \
    if ((++_sp & 255u) == 0u) { if (xb_ld(&(bar)[XB_TMO])) break; if (_sp > XB_SPIN_CAP) { atomicAdd(&(bar)[XB_TMO], 1u); break; } } } } while (0)

struct XcdBarrier { unsigned* bar; unsigned x; volatile LAS unsigned* st; };
__device__ __forceinline__ XcdBarrier xcd_barrier_post(unsigned* bar, volatile LAS unsigned* st) {
    XcdBarrier b; b.bar = bar; b.x = xb_xcc_id(); b.st = st;
    if (threadIdx.x == 0) { const unsigned r_ = xb_add(&bar[XB_XCNT(b.x)], 1u); st[2] = r_; }
    return b;
}
__device__ __forceinline__ void xcd_barrier_complete(unsigned* bar, unsigned x, unsigned& nloc, unsigned& nx) {
    const unsigned G = gridDim.x * gridDim.y * gridDim.z;
    unsigned sum, cnt, mine, sp = 0u;
    for (;;) {
        sum = 0u; cnt = 0u; mine = 0u;
#pragma unroll
        for (unsigned j = 0; j < 16; ++j) { const unsigned c = xb_ld(&bar[XB_XCNT(j)]); sum += c; cnt += (c > 0u) ? 1u : 0u; mine = (j == x) ? c : mine; }
        if (sum == G) break;
        __builtin_amdgcn_s_sleep(1);
        if ((++sp & 255u) == 0u) { if (xb_ld(&bar[XB_TMO])) break; if (sp > XB_SPIN_CAP) { atomicAdd(&bar[XB_TMO], 1u); break; } }
    }
    nloc = mine > 0u ? mine : 1u; nx = cnt > 0u ? cnt : 1u;
}

__device__ __forceinline__ void xcd_barrier(const XcdBarrier& b) {
    asm volatile("s_waitcnt vmcnt(0)" ::: "memory");
    __syncthreads();
    if (threadIdx.x == 0) {
        unsigned* bar = b.bar;
        __builtin_amdgcn_s_waitcnt(0);
        unsigned nloc = b.st[0], nx = b.st[1];
        if (nloc == 0u) { xcd_barrier_complete(bar, b.x, nloc, nx); b.st[0] = nloc; b.st[1] = nx; }
        const unsigned old = xb_add(&bar[XB_XSUB(b.x)], 1u);
        const unsigned gen = old / nloc;
        if (old + 1u == (gen + 1u) * nloc) {
            __builtin_amdgcn_fence(__ATOMIC_RELEASE, "agent");
            asm volatile("s_waitcnt vmcnt(0)" ::: "memory");
            const unsigned og = xb_add(&bar[XB_TOP], 1u);
            const unsigned tg = og / nx;
            if (og + 1u == (tg + 1u) * nx) xb_add(&bar[XB_TOPGEN], 1u);
            else XB_SPIN(xb_ld(&bar[XB_TOPGEN]) == tg, bar);
            __builtin_amdgcn_fence(__ATOMIC_ACQUIRE, "agent");
            xb_add(&bar[XB_XGEN(b.x)], 1u);
            asm volatile("s_waitcnt vmcnt(0)" ::: "memory");
        } else {
            XB_SPIN(xb_ld(&bar[XB_XGEN(b.x)]) == gen, bar);
            __builtin_amdgcn_fence(__ATOMIC_ACQUIRE, "agent");
            asm volatile("s_waitcnt vmcnt(0)" ::: "memory");
        }
    }
    __syncthreads();
}

struct Params { const float* in[23]; float* out; unsigned char* ws; int ph_lo, ph_hi, coop, pad; };

struct Frame {
    LAS unsigned char* lds;
    int tid, lane, wave, vcu, G, gw, NGW, bx;
    unsigned char* ws; bf16_t* hnbuf;
    int r0, rstep, rend, xcd, rank;
};

__device__ __forceinline__ void transpose_item(const float* W, int K, int Nsrc, bf16_t* WT, int dst_n0, int src_n0, int nvalid, const float* kgain, int k0, LAS float* scr, int lane) {
    const int srcn = src_n0 + (lane & 31);
#pragma unroll 32
    for (int i = 0; i < 32; ++i) { const int kk = 2 * i + (lane >> 5);
        float v = (srcn < nvalid) ? W[(size_t)(k0 + kk) * Nsrc + srcn] : 0.f;
        if (kgain) v *= kgain[k0 + kk];
        scr[kk * 33 + (lane & 31)] = v; }
    asm volatile("s_waitcnt lgkmcnt(0)" ::: "memory");
    const int c = lane & 7;
#pragma unroll
    for (int j = 0; j < 4; ++j) { const int n = (lane >> 3) + 8 * j; const LAS float* s = scr + (8 * c) * 33 + n;
        u32x4 o; o.x = cvt_pk_bf16(s[0 * 33], s[1 * 33]); o.y = cvt_pk_bf16(s[2 * 33], s[3 * 33]); o.z = cvt_pk_bf16(s[4 * 33], s[5 * 33]); o.w = cvt_pk_bf16(s[6 * 33], s[7 * 33]);
        *(u32x4*)(WT + (size_t)(dst_n0 + n) * K + k0 + 8 * c) = o; }
    asm volatile("s_waitcnt lgkmcnt(0)" ::: "memory");
}

__device__ __forceinline__ void convert_group(const Frame& F, const float* W, int nl, int K, int Nsrc, int Ndst, bf16_t* WT, int kind, const float* kgain, int gain_stride) {
    int tl_ = F.tid; asm volatile("" : "+v"(tl_)); const int lane_l = tl_ & 63;
    LAS float* scr = (LAS float*)(F.lds + F.wave * 16384);
    const int nblk = Ndst / 32, per = (K / 64) * nblk, total = nl * per;
    for (int it = F.gw; it < total; it += F.NGW) {
        const int l = it / per, r = it % per, kb = r / nblk, nb = r % nblk, dn0 = nb * 32;
        int sn0 = dn0;
        if (kind == 1) { const int j = dn0 >> 8, i0 = dn0 & 255; sn0 = (i0 < 128) ? (128 * j + i0) : (D_FF + 128 * j + i0 - 128); }
        transpose_item(W + (size_t)l * K * Nsrc, K, Nsrc, WT + (size_t)l * Ndst * K, dn0, sn0, Nsrc, kgain ? kgain + l * gain_stride : nullptr, kb * 64, scr, lane_l);
    }
}

__device__ __forceinline__ void phase_prologue(const Frame& F, const Params& p) {
    int tl_ = F.tid; asm volatile("" : "+v"(tl_)); const int lane_l = tl_ & 63;
    bf16_t* WB = (bf16_t*)(F.ws + WS_W);
    convert_group(F, p.in[5], 2, 1024, EIN_N, EIN_NP, WB + OW_EIN, 0, nullptr, 0);
    convert_group(F, p.in[8], 2, 384, 768, 768, WB + OW_EUQ, 0, p.in[7], 384);
    convert_group(F, p.in[10], 2, 256, 1024, 1024, WB + OW_EUKV, 0, p.in[9], 256);
    convert_group(F, p.in[11], 2, 1024, 1024, 1024, WB + OW_EOUT, 0, nullptr, 0);
    convert_group(F, p.in[12], 2, 1024, OIN_N, OIN_N, WB + OW_OIN, 0, nullptr, 0);
    convert_group(F, p.in[18], 2, 1024, 1024, 1024, WB + OW_OOUT, 0, nullptr, 0);
    convert_group(F, p.in[19], 4, 1024, 2 * D_FF, 2 * D_FF, WB + OW_UP, 1, nullptr, 0);
    convert_group(F, p.in[22], 4, D_FF, 1024, 1024, WB + OW_DN, 0, nullptr, 0);
    float* cosT = (float*)(F.ws + WS_COS); float* sinT = (float*)(F.ws + WS_SIN);
    for (int e = F.bx * NTHREADS + F.tid; e < SEQ * 16; e += F.G * NTHREADS) {
        const int pos = e >> 4, i = e & 15;
        const float inv = exp2f(-(float)i * 0.8304820237218406f);
        const float ang = (float)pos * inv;
        const float kq = rintf(ang * 0.6366197723675814f);
        float r = fmaf(-kq, 1.5703125f, ang); r = fmaf(-kq, 4.837512969970703125e-4f, r); r = fmaf(-kq, 7.54978995489188216e-8f, r);
        const float r2_ = r * r;
        const float sn = r + r * r2_ * (-1.6666666667e-1f + r2_ * (8.3333333333e-3f + r2_ * (-1.9841269841e-4f + r2_ * 2.7557319224e-6f)));
        const float cs = 1.0f + r2_ * (-0.5f + r2_ * (4.1666666667e-2f + r2_ * (-1.3888888889e-3f + r2_ * (2.4801587302e-5f + r2_ * -2.7557319224e-7f))));
        const int q4 = ((int)kq) & 3;
        const float s_ = (q4 == 0) ? sn : (q4 == 1) ? cs : (q4 == 2) ? -sn : -cs;
        const float c_ = (q4 == 0) ? cs : (q4 == 1) ? -sn : (q4 == 2) ? -cs : sn;
        cosT[e] = c_; sinT[e] = s_;
    }
    const float* x = p.in[0]; const float* g = p.in[1]; bf16_t* hn = F.hnbuf;
    f32x4 gg[4]; gg[0] = *(const f32x4*)(g + 8 * lane_l); gg[1] = *(const f32x4*)(g + 8 * lane_l + 4); gg[2] = *(const f32x4*)(g + 512 + 8 * lane_l); gg[3] = *(const f32x4*)(g + 512 + 8 * lane_l + 4);
    for (int row = F.r0; row < F.rend; row += 2 * F.rstep) {
        f32x4 v[2][4]; float ss[2];
#pragma unroll
        for (int q = 0; q < 2; ++q) { const float* xr = x + (size_t)(row + q * F.rstep) * 1024;
            v[q][0] = *(const f32x4*)(xr + 8 * lane_l); v[q][1] = *(const f32x4*)(xr + 8 * lane_l + 4); v[q][2] = *(const f32x4*)(xr + 512 + 8 * lane_l); v[q][3] = *(const f32x4*)(xr + 512 + 8 * lane_l + 4); }
#pragma unroll
        for (int q = 0; q < 2; ++q) { ss[q] = 0.f;
#pragma unroll
            for (int j = 0; j < 4; ++j) ss[q] += v[q][j][0] * v[q][j][0] + v[q][j][1] * v[q][j][1] + v[q][j][2] * v[q][j][2] + v[q][j][3] * v[q][j][3]; }
#pragma unroll
        for (int o = 1; o < 64; o <<= 1) { ss[0] += shflx(ss[0], o, lane_l); ss[1] += shflx(ss[1], o, lane_l); }
#pragma unroll
        for (int q = 0; q < 2; ++q) {
            const float r = rsqrtf(ss[q] * (1.0f / 1024.0f) + RMS_EPS);
            f32x4 y[4];
#pragma unroll
            for (int j = 0; j < 4; ++j) y[j] = v[q][j] * r * gg[j];
            u32x4 w0, w1;
            w0.x = cvt_pk_bf16(y[0][0], y[0][1]); w0.y = cvt_pk_bf16(y[0][2], y[0][3]); w0.z = cvt_pk_bf16(y[1][0], y[1][1]); w0.w = cvt_pk_bf16(y[1][2], y[1][3]);
            w1.x = cvt_pk_bf16(y[2][0], y[2][1]); w1.y = cvt_pk_bf16(y[2][2], y[2][3]); w1.z = cvt_pk_bf16(y[3][0], y[3][1]); w1.w = cvt_pk_bf16(y[3][2], y[3][3]);
            const size_t ro = (size_t)(row + q * F.rstep) * 1024;
            *(u32x4*)(hn + ro + 8 * lane_l) = w0; *(u32x4*)(hn + ro + 512 + 8 * lane_l) = w1;
        }
    }
}

template <bool XIN_F32, bool XOUT_F32>
__device__ __forceinline__ void phase_rowpost(const Frame& F, const bf16_t* mb, const void* xin_, void* xout_, const float* gpost, const float* gnext, bf16_t* hn) {
    int tl_ = F.tid; asm volatile("" : "+v"(tl_)); const int lane_l = tl_ & 63;
    const int c0 = 8 * lane_l, c1 = 512 + 8 * lane_l;
    f32x4 gp[4]; gp[0] = *(const f32x4*)(gpost + c0); gp[1] = *(const f32x4*)(gpost + c0 + 4); gp[2] = *(const f32x4*)(gpost + c1); gp[3] = *(const f32x4*)(gpost + c1 + 4);
    f32x4 gn[4];
#pragma unroll
    for (int j = 0; j < 4; ++j) gn[j] = (f32x4){0.f, 0.f, 0.f, 0.f};
    if (gnext) { gn[0] = *(const f32x4*)(gnext + c0); gn[1] = *(const f32x4*)(gnext + c0 + 4); gn[2] = *(const f32x4*)(gnext + c1); gn[3] = *(const f32x4*)(gnext + c1 + 4); }
    for (int row = F.r0; row < F.rend; row += 2 * F.rstep) {
        size_t ro[2]; ro[0] = (size_t)row * 1024; ro[1] = (size_t)(row + F.rstep) * 1024;
        u32x4 m0[2], m1[2]; f32x4 xv[2][4];
#pragma unroll
        for (int q = 0; q < 2; ++q) {
            m0[q] = *(const u32x4*)(mb + ro[q] + c0); m1[q] = *(const u32x4*)(mb + ro[q] + c1);
            if (XIN_F32) { const float* xin = (const float*)xin_;
                xv[q][0] = *(const f32x4*)(xin + ro[q] + c0); xv[q][1] = *(const f32x4*)(xin + ro[q] + c0 + 4); xv[q][2] = *(const f32x4*)(xin + ro[q] + c1); xv[q][3] = *(const f32x4*)(xin + ro[q] + c1 + 4);
            } else { const bf16_t* xin = (const bf16_t*)xin_;
                const u32x4 a0 = *(const u32x4*)(xin + ro[q] + c0), a1 = *(const u32x4*)(xin + ro[q] + c1);
                xv[q][0] = (f32x4){bf_lo(a0.x), bf_hi(a0.x), bf_lo(a0.y), bf_hi(a0.y)}; xv[q][1] = (f32x4){bf_lo(a0.z), bf_hi(a0.z), bf_lo(a0.w), bf_hi(a0.w)};
                xv[q][2] = (f32x4){bf_lo(a1.x), bf_hi(a1.x), bf_lo(a1.y), bf_hi(a1.y)}; xv[q][3] = (f32x4){bf_lo(a1.z), bf_hi(a1.z), bf_lo(a1.w), bf_hi(a1.w)};
            }
        }
        f32x4 mv[2][4]; float ss[2];
#pragma unroll
        for (int q = 0; q < 2; ++q) {
            mv[q][0] = (f32x4){bf_lo(m0[q].x), bf_hi(m0[q].x), bf_lo(m0[q].y), bf_hi(m0[q].y)}; mv[q][1] = (f32x4){bf_lo(m0[q].z), bf_hi(m0[q].z), bf_lo(m0[q].w), bf_hi(m0[q].w)};
            mv[q][2] = (f32x4){bf_lo(m1[q].x), bf_hi(m1[q].x), bf_lo(m1[q].y), bf_hi(m1[q].y)}; mv[q][3] = (f32x4){bf_lo(m1[q].z), bf_hi(m1[q].z), bf_lo(m1[q].w), bf_hi(m1[q].w)};
            ss[q] = 0.f;
#pragma unroll
            for (int j = 0; j < 4; ++j) ss[q] += mv[q][j][0] * mv[q][j][0] + mv[q][j][1] * mv[q][j][1] + mv[q][j][2] * mv[q][j][2] + mv[q][j][3] * mv[q][j][3];
        }
#pragma unroll
        for (int o = 1; o < 64; o <<= 1) { ss[0] += shflx(ss[0], o, lane_l); ss[1] += shflx(ss[1], o, lane_l); }
        float s2[2];
#pragma unroll
        for (int q = 0; q < 2; ++q) {
            const float r1 = rsqrtf(ss[q] * (1.0f / 1024.0f) + RMS_EPS);
            s2[q] = 0.f;
#pragma unroll
            for (int j = 0; j < 4; ++j) { xv[q][j] = xv[q][j] + mv[q][j] * r1 * gp[j]; s2[q] += xv[q][j][0] * xv[q][j][0] + xv[q][j][1] * xv[q][j][1] + xv[q][j][2] * xv[q][j][2] + xv[q][j][3] * xv[q][j][3]; }
            if (XOUT_F32) { float* xout = (float*)xout_;
                *(f32x4*)(xout + ro[q] + c0) = xv[q][0]; *(f32x4*)(xout + ro[q] + c0 + 4) = xv[q][1]; *(f32x4*)(xout + ro[q] + c1) = xv[q][2]; *(f32x4*)(xout + ro[q] + c1 + 4) = xv[q][3];
            } else { bf16_t* xout = (bf16_t*)xout_; u32x4 w0, w1;
                w0.x = cvt_pk_bf16(xv[q][0][0], xv[q][0][1]); w0.y = cvt_pk_bf16(xv[q][0][2], xv[q][0][3]); w0.z = cvt_pk_bf16(xv[q][1][0], xv[q][1][1]); w0.w = cvt_pk_bf16(xv[q][1][2], xv[q][1][3]);
                w1.x = cvt_pk_bf16(xv[q][2][0], xv[q][2][1]); w1.y = cvt_pk_bf16(xv[q][2][2], xv[q][2][3]); w1.z = cvt_pk_bf16(xv[q][3][0], xv[q][3][1]); w1.w = cvt_pk_bf16(xv[q][3][2], xv[q][3][3]);
                *(u32x4*)(xout + ro[q] + c0) = w0; *(u32x4*)(xout + ro[q] + c1) = w1;
            }
        }
        if (gnext) {
#pragma unroll
            for (int o = 1; o < 64; o <<= 1) { s2[0] += shflx(s2[0], o, lane_l); s2[1] += shflx(s2[1], o, lane_l); }
#pragma unroll
            for (int q = 0; q < 2; ++q) {
                const float r2 = rsqrtf(s2[q] * (1.0f / 1024.0f) + RMS_EPS);
                f32x4 y[4];
#pragma unroll
                for (int j = 0; j < 4; ++j) y[j] = xv[q][j] * r2 * gn[j];
                u32x4 w0, w1;
                w0.x = cvt_pk_bf16(y[0][0], y[0][1]); w0.y = cvt_pk_bf16(y[0][2], y[0][3]); w0.z = cvt_pk_bf16(y[1][0], y[1][1]); w0.w = cvt_pk_bf16(y[1][2], y[1][3]);
                w1.x = cvt_pk_bf16(y[2][0], y[2][1]); w1.y = cvt_pk_bf16(y[2][2], y[2][3]); w1.z = cvt_pk_bf16(y[3][0], y[3][1]); w1.w = cvt_pk_bf16(y[3][2], y[3][3]);
                *(u32x4*)(hn + ro[q] + c0) = w0; *(u32x4*)(hn + ro[q] + c1) = w1;
            }
        }
    }
}

__device__ __forceinline__ float sumsq8(u32x4 v) {
    const float a = bf_lo(v.x), b = bf_hi(v.x), c = bf_lo(v.y), d = bf_hi(v.y), e = bf_lo(v.z), f = bf_hi(v.z), g = bf_lo(v.w), h = bf_hi(v.w);
    return (a * a + b * b) + (c * c + d * d) + (e * e + f * f) + (g * g + h * h);
}

__device__ __forceinline__ void phase_even_small(const Frame& F, const Params& p, int li) {
    int tl_ = F.tid; asm volatile("" : "+v"(tl_)); const int lane_l = tl_ & 63;
    const bf16_t* proj = (const bf16_t*)(F.ws + WS_PROJ);
    float* rq = (float*)(F.ws + WS_RSTDQ); float* rkv = (float*)(F.ws + WS_RSTDKV);
    bf16_t* krope = (bf16_t*)(F.ws + WS_KROPE);
    const float* cosT = (const float*)(F.ws + WS_COS); const float* sinT = (const float*)(F.ws + WS_SIN);
    for (int t0 = F.r0; t0 < F.rend; t0 += 4 * F.rstep) {
        u32x4 cq[4], ckv[4]; float x1[4], x2[4], cs[4], sn[4];
#pragma unroll
        for (int q = 0; q < 4; ++q) {
            const int t = t0 + q * F.rstep; const bf16_t* pr = proj + (size_t)t * EIN_NP;
            cq[q] = (u32x4){0, 0, 0, 0}; ckv[q] = (u32x4){0, 0, 0, 0}; x1[q] = 0.f; x2[q] = 0.f; cs[q] = 0.f; sn[q] = 0.f;
            if (lane_l < 48) cq[q] = *(const u32x4*)(pr + C_CQ + 8 * lane_l);
            if (lane_l < 32) ckv[q] = *(const u32x4*)(pr + C_CKV + 8 * lane_l);
            if (lane_l < 16) { x1[q] = bf2f(pr[C_KR + lane_l]); x2[q] = bf2f(pr[C_KR + 16 + lane_l]); const int pos = t & (SEQ - 1); cs[q] = cosT[pos * 16 + lane_l]; sn[q] = sinT[pos * 16 + lane_l]; }
        }
        float sq[4], skv[4];
#pragma unroll
        for (int q = 0; q < 4; ++q) { sq[q] = sumsq8(cq[q]); skv[q] = sumsq8(ckv[q]); }
#pragma unroll
        for (int o = 1; o < 64; o <<= 1) {
#pragma unroll
            for (int q = 0; q < 4; ++q) { sq[q] += shflx(sq[q], o, lane_l); skv[q] += shflx(skv[q], o, lane_l); }
        }
#pragma unroll
        for (int q = 0; q < 4; ++q) {
            const int t = t0 + q * F.rstep;
            if (lane_l == 0) { rq[t] = rsqrtf(sq[q] * (1.0f / 384.0f) + RMS_EPS); rkv[t] = rsqrtf(skv[q] * (1.0f / 256.0f) + RMS_EPS); }
            if (lane_l < 16) {
                const unsigned a = cvt_pk_bf16(x1[q] * cs[q] - x2[q] * sn[q], x1[q] * sn[q] + x2[q] * cs[q]);
                krope[(size_t)t * 32 + lane_l] = (bf16_t)(a & 0xffffu); krope[(size_t)t * 32 + 16 + lane_l] = (bf16_t)(a >> 16);
            }
        }
    }
    float* ccum = (float*)(F.ws + WS_CCUM);
    LAS float* tot = (LAS float*)(F.lds);
    for (int bh = F.bx; bh < 64; bh += F.G) {
        const int b = bh >> 3, h = bh & 7;
        const float bf = p.in[6][li * 8 + h];
        float v[8]; float carry = 0.f;
#pragma unroll
        for (int j = 0; j < 8; ++j) {
            const int s = 512 * F.wave + 64 * j + lane_l;
            const float xg = bf2f(proj[((size_t)b * SEQ + s) * EIN_NP + C_FG + h]) + bf;
            float ls = (xg >= 0.f) ? -log1pf(expf(-xg)) : (xg - log1pf(expf(xg)));
#pragma unroll
            for (int d = 1; d < 64; d <<= 1) { const float t_ = __int_as_float(__builtin_amdgcn_ds_bpermute(((lane_l - d) & 63) << 2, __float_as_int(ls))); if (lane_l >= d) ls += t_; }
            v[j] = ls + carry;
            carry = __int_as_float(__builtin_amdgcn_readlane(__float_as_int(v[j]), 63));
        }
        __syncthreads();
        if (lane_l == 0) tot[F.wave] = carry;
        __syncthreads();
        float off = 0.f;
#pragma unroll
        for (int w = 0; w < 8; ++w) { const float tw = tot[w]; if (w < F.wave) off += tw; }
#pragma unroll
        for (int j = 0; j < 8; ++j) ccum[(size_t)bh * SEQ + 512 * F.wave + 64 * j + lane_l] = (v[j] + off) * LOG2E;
    }
}

__device__ __forceinline__ void phase_odd_post(const Frame& F, const Params& p, int layer) {
    int tl_ = F.tid; asm volatile("" : "+v"(tl_)); const int lane_l = tl_ & 63;
    const int li = layer >> 1;
    const float linit = 0.8f - 0.6f * expf(-0.3f * (float)layer);
    const float s1 = wave_sum(p.in[13][li * 64 + lane_l] * p.in[14][li * 64 + lane_l], lane_l);
    const float s2 = wave_sum(p.in[15][li * 64 + lane_l] * p.in[16][li * 64 + lane_l], lane_l);
    const float lam = expf(s1) - expf(s2) + linit;
    const bf16_t* Oa = (const bf16_t*)(F.ws + WS_R2); const bf16_t* Ob = (const bf16_t*)(F.ws + WS_R2 + R2_OB);
    bf16_t* outb = F.hnbuf;
    const float* sub = p.in[17] + li * 128 + (16 * lane_l & 127);
    f32x4 sg[4];
#pragma unroll
    for (int j = 0; j < 4; ++j) sg[j] = *(const f32x4*)(sub + 4 * j) * (1.0f - linit);
    for (int row = F.r0; row < F.rend; row += 2 * F.rstep) {
        size_t ro[2]; ro[0] = (size_t)row * 1024 + 16 * lane_l; ro[1] = (size_t)(row + F.rstep) * 1024 + 16 * lane_l;
        u32x4 a0[2], a1[2], b0[2], b1[2];
#pragma unroll
        for (int q = 0; q < 2; ++q) { a0[q] = *(const u32x4*)(Oa + ro[q]); a1[q] = *(const u32x4*)(Oa + ro[q] + 8); b0[q] = *(const u32x4*)(Ob + ro[q]); b1[q] = *(const u32x4*)(Ob + ro[q] + 8); }
#pragma unroll
        for (int q = 0; q < 2; ++q) {
            f32x4 v[4];
            v[0] = (f32x4){bf_lo(a0[q].x) - lam * bf_lo(b0[q].x), bf_hi(a0[q].x) - lam * bf_hi(b0[q].x), bf_lo(a0[q].y) - lam * bf_lo(b0[q].y), bf_hi(a0[q].y) - lam * bf_hi(b0[q].y)};
            v[1] = (f32x4){bf_lo(a0[q].z) - lam * bf_lo(b0[q].z), bf_hi(a0[q].z) - lam * bf_hi(b0[q].z), bf_lo(a0[q].w) - lam * bf_lo(b0[q].w), bf_hi(a0[q].w) - lam * bf_hi(b0[q].w)};
            v[2] = (f32x4){bf_lo(a1[q].x) - lam * bf_lo(b1[q].x), bf_hi(a1[q].x) - lam * bf_hi(b1[q].x), bf_lo(a1[q].y) - lam * bf_lo(b1[q].y), bf_hi(a1[q].y) - lam * bf_hi(b1[q].y)};
            v[3] = (f32x4){bf_lo(a1[q].z) - lam * bf_lo(b1[q].z), bf_hi(a1[q].z) - lam * bf_hi(b1[q].z), bf_lo(a1[q].w) - lam * bf_lo(b1[q].w), bf_hi(a1[q].w) - lam * bf_hi(b1[q].w)};
            float ss = 0.f;
#pragma unroll
            for (int j = 0; j < 4; ++j) ss += v[j][0] * v[j][0] + v[j][1] * v[j][1] + v[j][2] * v[j][2] + v[j][3] * v[j][3];
            ss += shflx(ss, 1, lane_l); ss += shflx(ss, 2, lane_l); ss += shflx(ss, 4, lane_l);
            const float r = rsqrtf(ss * (1.0f / 128.0f) + RMS_EPS);
#pragma unroll
            for (int j = 0; j < 4; ++j) v[j] = v[j] * r * sg[j];
            u32x4 w0, w1;
            w0.x = cvt_pk_bf16(v[0][0], v[0][1]); w0.y = cvt_pk_bf16(v[0][2], v[0][3]); w0.z = cvt_pk_bf16(v[1][0], v[1][1]); w0.w = cvt_pk_bf16(v[1][2], v[1][3]);
            w1.x = cvt_pk_bf16(v[2][0], v[2][1]); w1.y = cvt_pk_bf16(v[2][2], v[2][3]); w1.z = cvt_pk_bf16(v[3][0], v[3][1]); w1.w = cvt_pk_bf16(v[3][2], v[3][3]);
            *(u32x4*)(outb + ro[q]) = w0; *(u32x4*)(outb + ro[q] + 8) = w1;
        }
    }
}

__device__ __forceinline__ void phase_ffn_fix(const Frame& F, const float* cw, const float* cb) {
    const float* halo = (const float*)(F.ws + WS_R2 + R2_HALO); const float* part = (const float*)(F.ws + WS_R2 + R2_PART); const float* val01 = (const float*)(F.ws + WS_R2 + R2_VAL);
    bf16_t* act = (bf16_t*)(F.ws + WS_PROJ);
    constexpr int CG = D_FF / 4, TOT = (MTOK / 64) * 2 * CG;
    const bool byx = (F.G == 256);
    for (int it = (byx ? F.rank : F.bx) * NTHREADS + F.tid; it < (byx ? TOT / 8 : TOT); it += (byx ? 32 : F.G) * NTHREADS) {
        const int cgi = it % CG, rr = (it / CG) & 1, chunk = (byx ? F.xcd * 64 : 0) + it / (2 * CG), col = 4 * cgi;
        const int prev = chunk > 0 ? chunk - 1 : 0; const float hm = (chunk & 63) ? 1.0f : 0.0f;
        f32x4 cv = *(const f32x4*)(part + (size_t)(chunk * 2 + rr) * D_FF + col);
        const f32x4 v = *(const f32x4*)(val01 + (size_t)(chunk * 2 + rr) * D_FF + col);
        const f32x4 h0 = *(const f32x4*)(halo + (size_t)(prev * 2 + 0) * D_FF + col), h1 = *(const f32x4*)(halo + (size_t)(prev * 2 + 1) * D_FF + col);
        const f32x4 w0 = *(const f32x4*)(cw + col), w1 = *(const f32x4*)(cw + D_FF + col);
        const f32x4 add = (rr == 0) ? (w1 * h1 + w0 * h0) : (w0 * h1);
        cv = cv + add * hm;
        u32x2 w; w.x = cvt_pk_bf16(gelu_tanh(cv[0]) * v[0], gelu_tanh(cv[1]) * v[1]); w.y = cvt_pk_bf16(gelu_tanh(cv[2]) * v[2], gelu_tanh(cv[3]) * v[3]);
        *(u32x2*)(act + (size_t)(chunk * 64 + rr) * D_FF + col) = w;
    }
}

__device__ __forceinline__ void phase_attn_even(const Frame& F, const int pm) {
    const bf16_t* proj = (const bf16_t*)(F.ws + WS_PROJ);
    const bf16_t* qmla = (const bf16_t*)(F.ws + WS_R2); const bf16_t* kvmla = (const bf16_t*)(F.ws + WS_R2 + R2_KVMLA);
    const bf16_t* krope = (const bf16_t*)(F.ws + WS_KROPE);
    bf16_t* ao = F.hnbuf;
    const float* ccum = (const float*)(F.ws + WS_CCUM);
    for (int it_ = 0; it_ < (F.G == 256 ? 4 : (1024 + F.G - 1) / F.G); ++it_) {
        int item;
        if (F.G == 256) { const int li = F.rank + 32 * it_; item = (li >> 6) * 512 + (F.xcd * 8 + ((li & 63) >> 3)) * 8 + (li & 7); }
        else { item = F.vcu + it_ * F.G; if (item >= 1024) break; }
        const int stream = item >> 9, rem = item & 511, bh = rem >> 3, pr = rem & 7, b = bh >> 3, h = bh & 7;
        const size_t rowbase = (size_t)b * SEQ;
        AttnP P;
        if (stream == 0) {
            P.Q = proj + C_FQ + h * 64; P.ldq = EIN_NP; P.K1 = proj + C_FK + h * 64; P.ldk1 = EIN_NP; P.K2 = nullptr; P.V = proj + C_FV + h * 64; P.ldv = EIN_NP;
            P.O = ao + h * 64; P.ldo = 1024; P.bias = ccum + (size_t)bh * SEQ; P.sl2 = 0.f; P.Oprev = nullptr; P.subln = nullptr; P.lam = 0.f; P.osc = 0.f;
            attn_unit<64, 64, 0>(F.lds, P, rowbase, 15 - pr, F.tid, pm);
            attn_unit<64, 64, 0>(F.lds, P, rowbase, pr, F.tid, pm);
        } else {
            P.Q = qmla + h * 96; P.ldq = 768; P.K1 = kvmla + h * 128; P.ldk1 = 1024; P.K2 = krope; P.V = kvmla + h * 128 + 64; P.ldv = 1024;
            P.O = ao + 512 + h * 64; P.ldo = 1024; P.bias = nullptr; P.sl2 = 0.f; P.Oprev = nullptr; P.subln = nullptr; P.lam = 0.f; P.osc = 0.f;
            attn_unit<96, 64, 1>(F.lds, P, rowbase, 15 - pr, F.tid, pm);
            attn_unit<96, 64, 1>(F.lds, P, rowbase, pr, F.tid, pm);
        }
    }
}
__device__ __forceinline__ void phase_attn_odd(const Frame& F, const Params& p, const int layer, const int pm) {
    int tid_l = F.tid; asm volatile("" : "+v"(tid_l));
    const int lane_l = tid_l & 63, li_ = layer >> 1;
    const bf16_t* proj = (const bf16_t*)(F.ws + WS_PROJ);
    bf16_t* Oa = (bf16_t*)(F.ws + WS_R2); bf16_t* ao = F.hnbuf;
    const float linit = 0.8f - 0.6f * expf(-0.3f * (float)layer);
    const float s1 = wave_sum(p.in[13][li_ * 64 + lane_l] * p.in[14][li_ * 64 + lane_l], lane_l);
    const float s2 = wave_sum(p.in[15][li_ * 64 + lane_l] * p.in[16][li_ * 64 + lane_l], lane_l);
    const float lam = expf(s1) - expf(s2) + linit;
    for (int it_ = 0; it_ < (F.G == 256 ? 2 : (512 + F.G - 1) / F.G); ++it_) {
        int item;
        if (F.G == 256) { const int li = F.rank + 32 * it_; item = (F.xcd * 8 + (li >> 3)) * 8 + (li & 7); }
        else { item = F.vcu + it_ * F.G; if (item >= 512) break; }
        const int bh = item >> 3, pr = item & 7, b = bh >> 3, h = bh & 7;
        const size_t rowbase = (size_t)b * SEQ;
        for (int half = 0; half < 2; ++half) {
            const int qb = half ? pr : 15 - pr;
            for (int w2 = 0; w2 < 2; ++w2) {
                const int hp = 2 * h + w2;
                AttnP P;
                P.Q = proj + hp * 64; P.ldq = OIN_N; P.K1 = proj + 1024 + hp * 64; P.ldk1 = OIN_N; P.K2 = nullptr; P.V = proj + 2048 + h * 128; P.ldv = OIN_N;
                P.ldo = 1024; P.bias = nullptr; P.sl2 = exp2f(-(float)(h + 1)) * LOG2E;
                P.O = (w2 ? ao : Oa) + h * 128; P.Oprev = w2 ? (const bf16_t*)(Oa + h * 128) : nullptr;
                P.subln = p.in[17] + li_ * 128; P.lam = lam; P.osc = 1.0f - linit;
                attn_unit<64, 128, 2>(F.lds, P, rowbase, qb, tid_l, pm);
            }
        }
    }
}

#ifndef PHMASK
#define PHMASK 0xffff
#endif
#ifndef PROBEMODE
#define PROBEMODE 0
#endif
#ifndef SYNC2
#define SYNC2 0
#endif
#ifndef REPMASK
#define REPMASK 0
#endif
enum { K_PRO = 0, K_GIN = 1, K_ESMALL = 2, K_EGEMM = 3, K_ATTN = 4, K_OPOST = 5, K_GOUT = 6, K_ROWMIX = 7, K_F1 = 8, K_F2 = 9, K_F3 = 10, K_ROWFFN = 11 };
constexpr int NPHASES = 1 + 2 * 18;

__global__ void __launch_bounds__(NTHREADS) mega_kernel(Params p_) {
    extern __shared__ __attribute__((aligned(16))) unsigned char lds_raw[];
    const int ph_lo = p_.ph_lo, ph_hi = p_.ph_hi, coop = p_.coop;
    const int wave_s = __builtin_amdgcn_readfirstlane((int)threadIdx.x >> 6);
    if (coop) {
        volatile LAS unsigned* st_ = (volatile LAS unsigned*)((LAS unsigned char*)lds_raw + 131072 + 64);
        if (threadIdx.x < 4) st_[threadIdx.x] = (threadIdx.x == 3) ? blockIdx.x : 0u;
        __syncthreads();
        (void)xcd_barrier_post((unsigned*)p_.ws, st_);
    } else {
        volatile LAS unsigned* st_ = (volatile LAS unsigned*)((LAS unsigned char*)lds_raw + 131072 + 64);
        if (threadIdx.x == 0) st_[3] = blockIdx.x;
        __syncthreads();
    }
    int rep_done = 0;
    for (int ph = ph_lo; ph < ph_hi; ) {
    const __attribute__((address_space(4))) Params* pp_ = (const __attribute__((address_space(4))) Params*)__builtin_amdgcn_kernarg_segment_ptr(); asm volatile("" : "+s"(pp_));
    const Params& p = *(const Params*)pp_;
    Frame F;
    F.lds = (LAS unsigned char*)lds_raw;
    { int ws_ = wave_s; asm volatile("" : "+s"(ws_)); unsigned z_ = 0u; asm volatile("" : "+s"(z_)); int t_ = ws_ * 64 + (int)__builtin_amdgcn_mbcnt_hi(~0u, __builtin_amdgcn_mbcnt_lo(~0u, z_)); asm volatile("" : "+v"(t_)); F.tid = t_; }
    F.lane = F.tid & 63; F.wave = __builtin_amdgcn_readfirstlane(F.tid >> 6);
    { unsigned a_ = 131072u + 64u + 12u; asm volatile("" : "+v"(a_)); int b_ = __builtin_amdgcn_readfirstlane((int)*(volatile LAS unsigned*)(F.lds + a_)); asm volatile("" : "+s"(b_)); F.bx = b_; }
    F.G = gridDim.x; { const int bx = F.bx; F.vcu = (F.G % 8 == 0) ? (bx % 8) * (F.G / 8) + bx / 8 : bx; }
    F.gw = F.vcu * NWAVES + F.wave; F.NGW = F.G * NWAVES;
    F.xcd = F.bx & 7; F.rank = F.bx >> 3;
    if (F.G == 256) { F.r0 = F.xcd * SEQ + F.rank * NWAVES + F.wave; F.rstep = 256; F.rend = (F.xcd + 1) * SEQ; }
    else { F.r0 = F.gw; F.rstep = F.NGW; F.rend = MTOK; }
    F.ws = p.ws;
    bf16_t* WB = (bf16_t*)(F.ws + WS_W);
    F.hnbuf = (bf16_t*)p.out;
    bf16_t* hn = F.hnbuf;
    bf16_t* xb = (bf16_t*)(F.ws + WS_HN);
    bf16_t* proj = (bf16_t*)(F.ws + WS_PROJ);
    bf16_t* r2 = (bf16_t*)(F.ws + WS_R2);
        int layer = 0, kind = K_PRO;
        if (ph > 0) { const int r = ph - 1, pi = r / 18, rr = r % 18; const bool odd = rr >= 10; layer = 2 * pi + (odd ? 1 : 0); const int idx = odd ? rr - 10 : rr;
            kind = odd ? (idx == 0 ? K_GIN : idx == 1 ? K_ATTN : idx + 4) : (idx < 4 ? idx + 1 : idx + 2); }
        const int li = layer >> 1; const bool oddl = layer & 1;
        const int pm_ = (PROBEMODE && !rep_done) ? PROBEMODE : 0;
        if (kind == K_PRO) {
            if (PHMASK & 1) phase_prologue(F, p);
        } else if (kind == K_GIN || kind == K_GOUT || kind == K_F3) {
            pg8::Gemm g; EpiStore E; E.rowscale = nullptr; E.rs_mul = 1.f; E.ropec = nullptr; E.ropes = nullptr; E.s0 = 0.125f * LOG2E; E.scale_cols = 0;
            if (kind == K_GIN) {
                if (!oddl) { g = pg8::Gemm{hn, WB + OW_EIN + (size_t)li * EIN_NP * 1024, MTOK, EIN_NP, 1024, 1024, 1024}; E.O = proj; E.ldc = EIN_NP; E.scale_cols = 512; }
                else { g = pg8::Gemm{hn, WB + OW_OIN + (size_t)li * OIN_N * 1024, MTOK, OIN_N, 1024, 1024, 1024}; E.O = proj; E.ldc = OIN_N; E.scale_cols = 1024; }
            } else if (kind == K_GOUT) {
                g = pg8::Gemm{hn, WB + (oddl ? OW_OOUT : OW_EOUT) + (size_t)li * 1024 * 1024, MTOK, 1024, 1024, 1024, 1024}; E.O = r2; E.ldc = 1024;
            } else {
                g = pg8::Gemm{proj, WB + OW_DN + (size_t)layer * 1024 * D_FF, MTOK, 1024, D_FF, D_FF, D_FF}; E.O = r2; E.ldc = 1024;
            }
            pg8::StaticOrder S; S.init(g.M, g.N, F.G, F.bx);
            if (PHMASK & 2) pg8::gemm_phase<EpiStore, pg8::StaticOrder, true>(F.lds, g, S, E, F.tid);
        } else if (kind == K_ESMALL) {
            if (PHMASK & 4) phase_even_small(F, p, li);
        } else if (kind == K_EGEMM) {
            for (int which = 0; which < 2; ++which) {
                pg8::Gemm g; EpiStore E; E.scale_cols = 0; E.s0 = 1.f;
                if (which == 0) { g = pg8::Gemm{proj + C_CQ, WB + OW_EUQ + (size_t)li * 768 * 384, MTOK, 768, 384, EIN_NP, 384};
                    E.O = r2; E.ldc = 768; E.rowscale = (const float*)(F.ws + WS_RSTDQ); E.rs_mul = 0.10206207261596577f * LOG2E; E.ropec = (const float*)(F.ws + WS_COS); E.ropes = (const float*)(F.ws + WS_SIN); }
                else { g = pg8::Gemm{proj + C_CKV, WB + OW_EUKV + (size_t)li * 1024 * 256, MTOK, 1024, 256, EIN_NP, 256};
                    E.O = (bf16_t*)(F.ws + WS_R2 + R2_KVMLA); E.ldc = 1024; E.rowscale = (const float*)(F.ws + WS_RSTDKV); E.rs_mul = 1.f; E.ropec = nullptr; E.ropes = nullptr; }
                pg8::StaticOrder S; S.init(g.M, g.N, F.G, F.bx);
                if (PHMASK & 8) pg8::gemm_phase<EpiStore, pg8::StaticOrder, true>(F.lds, g, S, E, F.tid);
            }
        } else if (kind == K_ATTN) {
            if (!oddl) { if (PHMASK & 16) phase_attn_even(F, pm_); } else { if (PHMASK & 32) phase_attn_odd(F, p, layer, pm_); }
        } else if (kind == K_OPOST) {
            if (PHMASK & 64) phase_odd_post(F, p, layer);
        } else if (kind == K_ROWMIX) {
            if (layer == 0) phase_rowpost<true, false>(F, r2, p.in[0], xb, p.in[2] + layer * 1024, p.in[3] + layer * 1024, hn);
            else phase_rowpost<false, false>(F, r2, xb, xb, p.in[2] + layer * 1024, p.in[3] + layer * 1024, hn);
        } else if (kind == K_F1) {
            pg8::Gemm g{hn, WB + OW_UP + (size_t)layer * 5632 * 1024, MTOK, 2 * D_FF, 1024, 1024, 1024};
            EpiConv E{proj, p.in[20] + (size_t)layer * 3 * D_FF, p.in[21] + (size_t)layer * D_FF, (float*)(F.ws + WS_R2 + R2_HALO), (float*)(F.ws + WS_R2 + R2_PART), (float*)(F.ws + WS_R2 + R2_VAL)};
            pg8::StaticOrder S; S.init(g.M, g.N, F.G, F.bx);
            if (PHMASK & 256) pg8::gemm_phase<EpiConv, pg8::StaticOrder, true>(F.lds, g, S, E, F.tid);
        } else if (kind == K_F2) {
            if (PHMASK & 512) phase_ffn_fix(F, p.in[20] + (size_t)layer * 3 * D_FF, p.in[21] + (size_t)layer * D_FF);
        } else if (kind == K_ROWFFN) {
            if (layer + 1 < DEPTH) phase_rowpost<false, false>(F, r2, xb, xb, p.in[4] + layer * 1024, p.in[1] + (layer + 1) * 1024, hn);
            else phase_rowpost<false, true>(F, r2, xb, p.out, p.in[4] + layer * 1024, nullptr, hn);
        }
        if (coop && ph + 1 < ph_hi) {
            if (ph == 0) {
                cg::this_grid().sync();
                volatile LAS unsigned* st_ = (volatile LAS unsigned*)(F.lds + 131072 + 64);
                if (threadIdx.x == 0) {
                    unsigned* bar_ = (unsigned*)F.ws; bool ok_ = (gridDim.x % 8u) == 0u;
                    for (unsigned j = 0; j < 16; ++j) { const unsigned c_ = xb_ld(&bar_[XB_XCNT(j)]); ok_ = ok_ && (c_ == (j < 8u ? gridDim.x / 8u : 0u)); }
                    const unsigned x_ = xb_xcc_id();
                    st_[3] = (ok_ && x_ < 8u && st_[2] < gridDim.x / 8u) ? (st_[2] * 8u + x_) : blockIdx.x;
                }
                __syncthreads();
            }
            else { XcdBarrier xb_; xb_.bar = (unsigned*)F.ws; xb_.x = xb_xcc_id(); xb_.st = (volatile LAS unsigned*)(F.lds + 131072 + 64); xcd_barrier(xb_); if (SYNC2) xcd_barrier(xb_); }
        }
        if (((REPMASK >> kind) & 1) && !rep_done) { rep_done = 1; } else { rep_done = 0; ++ph; }
    }
}

#ifndef MK_MULTI
#define MK_MULTI 0
#endif

extern "C" void kernel_launch(void* const* d_in, const int* in_sizes, int n_in, void* d_out, int out_size, void* d_ws, size_t ws_size, hipStream_t stream) {
    static int grid = 0;
    if (grid == 0) {
        if (n_in != 23 || out_size != MTOK * D_MODEL || ws_size < WS_END) { fprintf(stderr, "kernel_launch: unexpected shapes (n_in %d out %d ws %zu need %zu)\n", n_in, out_size, ws_size, (size_t)WS_END); grid = -1; return; }
        int dev = 0, cus = 0, per_cu = 0;
        hipGetDevice(&dev); hipDeviceGetAttribute(&cus, hipDeviceAttributeMultiprocessorCount, dev);
        if (hipFuncSetAttribute((const void*)mega_kernel, hipFuncAttributeMaxDynamicSharedMemorySize, LDS_BYTES) != hipSuccess) { fprintf(stderr, "kernel_launch: hipFuncSetAttribute failed\n"); grid = -1; return; }
        hipOccupancyMaxActiveBlocksPerMultiprocessor(&per_cu, (const void*)mega_kernel, NTHREADS, LDS_BYTES);
        (void)hipGetLastError();
        if (per_cu < 1) fprintf(stderr, "kernel_launch: occupancy query says %d blocks/CU\n", per_cu);
        grid = cus;
    }
    if (grid < 0) return;
    Params p{};
    for (int i = 0; i < 23; ++i) p.in[i] = (const float*)d_in[i];
    p.out = (float*)d_out; p.ws = (unsigned char*)d_ws;
#if MK_MULTI
    for (int ph = 0; ph < NPHASES; ++ph) {
        p.ph_lo = ph; p.ph_hi = ph + 1; p.coop = 0;
        hipLaunchKernelGGL(mega_kernel, dim3(grid), dim3(NTHREADS), LDS_BYTES, stream, p);
    }
#else
    if (hipMemsetAsync(d_ws, 0, 65536, stream) != hipSuccess) { fprintf(stderr, "memset failed\n"); return; }
    p.ph_lo = 0; p.ph_hi = NPHASES; p.coop = 1;
    void* args[] = {&p};
    hipError_t e = hipLaunchCooperativeKernel((const void*)mega_kernel, dim3(grid), dim3(NTHREADS), args, LDS_BYTES, stream);
    if (e != hipSuccess) fprintf(stderr, "cooperative launch failed: %s (grid %d)\n", hipGetErrorString(e), grid);
#endif
}
```

```cpp
#include <hip/hip_runtime.h>
#include <hip/hip_cooperative_groups.h>
#include <cstdio>
#include <cstdint>
namespace cg = cooperative_groups;

#define LAS __attribute__((address_space(3)))
#ifndef KPF2
#define KPF2 true
#endif
typedef unsigned short bf16_t;
typedef short bf16x8 __attribute__((ext_vector_type(8)));
typedef short s16x4 __attribute__((ext_vector_type(4)));
typedef float f32x4 __attribute__((ext_vector_type(4)));
typedef float f32x16 __attribute__((ext_vector_type(16)));
typedef unsigned u32x4 __attribute__((ext_vector_type(4)));
typedef unsigned u32x2 __attribute__((ext_vector_type(2)));

constexpr int D_MODEL = 1024, BATCH = 8, SEQ = 4096, DEPTH = 4, MTOK = BATCH * SEQ;
constexpr int D_FF = 2816;
constexpr int EIN_N = 2216, EIN_NP = 2304;
constexpr int OIN_N = 3072;
constexpr float RMS_EPS = 1e-6f;
constexpr float LOG2E = 1.4426950408889634f;
constexpr float NEGBIG = -1e30f;
constexpr int C_FQ = 0, C_FK = 512, C_FV = 1024, C_FG = 1536, C_CQ = 1544, C_CKV = 1928, C_KR = 2184;

constexpr size_t MiB = 1u << 20;
constexpr size_t WS_RSTDQ = 128 * 1024, WS_RSTDKV = 256 * 1024;
constexpr size_t WS_CCUM = 1 * MiB, WS_KROPE = 2 * MiB, WS_COS = 4 * MiB, WS_SIN = 4 * MiB + 512 * 1024;
constexpr size_t WS_W = 8 * MiB;
constexpr size_t WS_HN = 112 * MiB;
constexpr size_t WS_PROJ = 176 * MiB;
constexpr size_t WS_R2 = 368 * MiB;
constexpr size_t WS_END = 496 * MiB;
constexpr size_t R2_KVMLA = 48 * MiB, R2_OB = 64 * MiB, R2_HALO = 64 * MiB, R2_PART = 76 * MiB, R2_VAL = 88 * MiB;
constexpr size_t OW_EIN = 0;
constexpr size_t OW_EUQ = OW_EIN + 2ull * EIN_NP * 1024;
constexpr size_t OW_EUKV = OW_EUQ + 2ull * 768 * 384;
constexpr size_t OW_EOUT = OW_EUKV + 2ull * 1024 * 256;
constexpr size_t OW_OIN = OW_EOUT + 2ull * 1024 * 1024;
constexpr size_t OW_OOUT = OW_OIN + 2ull * OIN_N * 1024;
constexpr size_t OW_UP = OW_OOUT + 2ull * 1024 * 1024;
constexpr size_t OW_DN = OW_UP + 4ull * 5632 * 1024;
constexpr size_t OW_END = OW_DN + 4ull * 1024 * D_FF;
static_assert(WS_W + OW_END * 2 <= WS_HN, "weights fit");

constexpr int LDS_BYTES = 135168;
constexpr int NTHREADS = 512, NWAVES = 8;

__device__ __forceinline__ unsigned cvt_pk_bf16(float lo, float hi) { unsigned r; asm volatile("v_cvt_pk_bf16_f32 %0, %1, %2" : "=v"(r) : "v"(lo), "v"(hi)); return r; }
__device__ __forceinline__ float bf_lo(unsigned w) { return __uint_as_float(w << 16); }
__device__ __forceinline__ float bf_hi(unsigned w) { return __uint_as_float(w & 0xffff0000u); }
__device__ __forceinline__ float bf2f(bf16_t v) { return __uint_as_float(((unsigned)v) << 16); }
__device__ __forceinline__ float shflx(float v, int m, int lane) { return __int_as_float(__builtin_amdgcn_ds_bpermute((lane ^ m) << 2, __float_as_int(v))); }
__device__ __forceinline__ float wave_sum(float v, int lane) {
#pragma unroll
    for (int o = 1; o < 64; o <<= 1) v += shflx(v, o, lane);
    return v;
}
__device__ __forceinline__ float gelu_tanh(float x) {
    const float u = 0.7978845608028654f * (x + 0.044715f * x * x * x);
    const float e = __builtin_amdgcn_exp2f(-2.0f * LOG2E * u);
    return x * __builtin_amdgcn_rcpf(1.0f + e);
}

namespace pg8 {
constexpr int BM = 256, BK = 64, HALF = 128, HTB = HALF * BK * 2, STAGE_BYTES = 8 * HTB, NXCD = 8, WGM = 8;
__host__ __device__ __forceinline__ int lds_byte(int r, int c) { const int st = (r >> 4) * 2 + (c >> 5), rr = r & 15, cc = c & 31, ob = rr * 64 + cc * 2; return st * 1024 + (ob ^ (((ob >> 9) & 1) << 5)); }
__host__ __device__ __forceinline__ void stage_rc(int b, int& R, int& C) { const int st = b / 1024, sb = b % 1024, swz = sb ^ (((sb >> 9) & 1) << 5); R = (st >> 1) * 16 + swz / 64; C = (st & 1) * 32 + (swz % 64) / 2; }
__host__ __device__ __forceinline__ int perm32(int rho) { const int n = rho >> 4, i = rho & 15; return 8 * (i >> 2) + 4 * n + (i & 3); }

struct Unit { int pm, pn; };
struct Gemm { const bf16_t* A; const bf16_t* Bt; int M, N, K, lda, ldb; };

struct StaticOrder {
    int nM, nN, nwg, G, c;
    __host__ __device__ void init(int M, int N, int G_, int c_) { nM = M / BM; nN = N / BM; nwg = nM * nN; G = G_; c = c_; }
    __host__ __device__ bool next(int i, Unit& u) const {
        const long L = (long)i * G + c; if (L >= nwg) return false;
        int wgid = (int)L; { const int q = nwg / NXCD, r = nwg % NXCD, xcd = wgid % NXCD, off = wgid / NXCD; wgid = (xcd < r ? xcd * (q + 1) : r * (q + 1) + (xcd - r) * q) + off; }
        const int nig = WGM * nN, gid = wgid / nig, fm = gid * WGM, gsz = (nM - fm) < WGM ? (nM - fm) : WGM;
        u.pm = fm + ((wgid % nig) % gsz); u.pn = (wgid % nig) / gsz; return true;
    }
};

template <class Epi, class Sched, bool ALIGN_EPI>
__device__ __forceinline__ void gemm_phase(LAS unsigned char* lds, const Gemm g, const Sched& S, const Epi& E, const int tid) {
    const int wid = __builtin_amdgcn_readfirstlane(tid >> 6), lane = tid & 63, wr = wid >> 2, wc = wid & 3, fr = lane & 15, fq = lane >> 4;
    const int K = g.K, nt = K / BK;
    unsigned voffA[2], voffB[2];
#pragma unroll
    for (int i = 0; i < 2; ++i) { int R, C; stage_rc(tid * 16 + i * 8192, R, C); const int Rb = (R & ~31) + perm32(R & 31);
        voffA[i] = (unsigned)(R * g.lda + C) * 2u; voffB[i] = (unsigned)(Rb * g.ldb + C) * 2u; }
    const size_t kstep = (size_t)(BK * 2);
    const size_t hstepA = (size_t)HALF * g.lda * 2, hstepB = (size_t)HALF * g.ldb * 2;
    const size_t tstepA = 2 * hstepA, tstepB = 2 * hstepB;
    const unsigned ldsw = (unsigned)wid * 1024u;
    const int aoff = lds_byte(wr * 64 + fr, fq * 8), boff = lds_byte(wc * 32 + fr, fq * 8);
#define PG8_SA(b, h) (((b) * 2 + (h)) * HTB)
#define PG8_SB(b, h) ((4 + (b) * 2 + (h)) * HTB)
#define PG8_STAGE(bufoff, gbase, voff) do { _Pragma("unroll") for (int _i = 0; _i < 2; ++_i) \
        __builtin_amdgcn_global_load_lds((const unsigned*)((const char*)(gbase) + (voff)[_i]), (LAS unsigned*)(lds + (bufoff) + ldsw + _i * 8192), 16, 0, 0); } while (0)
#define PG8_LDA(dst, b, h) do { _Pragma("unroll") for (int m = 0; m < 4; ++m) _Pragma("unroll") for (int k = 0; k < 2; ++k) dst[m][k] = *(const LAS bf16x8*)(lds + PG8_SA(b, h) + aoff + m * 2048 + k * 1024); } while (0)
#define PG8_LDB(dst, b, h) do { _Pragma("unroll") for (int n = 0; n < 2; ++n) _Pragma("unroll") for (int k = 0; k < 2; ++k) dst[n][k] = *(const LAS bf16x8*)(lds + PG8_SB(b, h) + boff + n * 2048 + k * 1024); } while (0)
#define PG8_MMA(ai, bj, At, Bt) do { __builtin_amdgcn_s_setprio(1); _Pragma("unroll") for (int m = 0; m < 4; ++m) _Pragma("unroll") for (int n = 0; n < 2; ++n) _Pragma("unroll") for (int k = 0; k < 2; ++k) \
        acc[ai][bj][m][n] = __builtin_amdgcn_mfma_f32_16x16x32_bf16(Bt[n][k], At[m][k], acc[ai][bj][m][n], 0, 0, 0); __builtin_amdgcn_s_setprio(0); } while (0)
#define PG8_WAIT_V(n) asm volatile("s_waitcnt vmcnt(" #n ")" ::: "memory")
#define PG8_WAIT_L(n) asm volatile("s_waitcnt lgkmcnt(" #n ")" ::: "memory")
#define PG8_BAR __builtin_amdgcn_s_barrier()
#define PG8_SCHED __builtin_amdgcn_sched_barrier(0)
    Unit cur, nxt; int ui = 0;
    if (!S.next(0, cur)) return;
    f32x4 acc[2][2][4][2];
#pragma unroll
    for (int a = 0; a < 2; ++a)
#pragma unroll
        for (int b = 0; b < 2; ++b)
#pragma unroll
            for (int m = 0; m < 4; ++m)
#pragma unroll
                for (int n = 0; n < 2; ++n) acc[a][b][m][n] = (f32x4){0.f, 0.f, 0.f, 0.f};
    bf16x8 At[4][2], B0[2][2], B1[2][2];
    const char* cA = (const char*)g.A + (size_t)cur.pm * tstepA; const char* cB = (const char*)g.Bt + (size_t)cur.pn * tstepB;
    PG8_STAGE(PG8_SB(0, 0), cB, voffB); PG8_STAGE(PG8_SB(0, 1), cB + hstepB, voffB); PG8_STAGE(PG8_SA(0, 0), cA, voffA); PG8_STAGE(PG8_SA(0, 1), cA + hstepA, voffA);
    if (wr == 1) PG8_BAR;
    PG8_WAIT_V(2); PG8_BAR;
    PG8_STAGE(PG8_SB(1, 0), cB + kstep, voffB); PG8_STAGE(PG8_SA(1, 0), cA + kstep, voffA); PG8_STAGE(PG8_SB(1, 1), cB + hstepB + kstep, voffB);
    PG8_WAIT_V(6); PG8_BAR;
    for (;;) {
        const bool has_next = S.next(ui + 1, nxt);
        const char* nA = has_next ? (const char*)g.A + (size_t)nxt.pm * tstepA : cA; const char* nB = has_next ? (const char*)g.Bt + (size_t)nxt.pn * tstepB : cB;
        for (int t = 0; t < nt; t += 2) {
            const bool last = (t == nt - 2);
            const char* a1 = cA + (size_t)(t + 1) * kstep;
            const char* a2 = last ? nA : cA + (size_t)(t + 2) * kstep; const char* b2 = last ? nB : cB + (size_t)(t + 2) * kstep;
            const char* a3 = a2 + kstep; const char* b3 = b2 + kstep;
            PG8_LDB(B0, 0, 0); PG8_LDB(B1, 0, 1); PG8_SCHED; PG8_LDA(At, 0, 0); PG8_STAGE(PG8_SA(1, 1), a1 + hstepA, voffA);
            PG8_WAIT_V(8); PG8_WAIT_L(0); PG8_BAR; PG8_MMA(0, 0, At, B0); PG8_MMA(0, 1, At, B1); PG8_BAR; PG8_SCHED;
            PG8_LDA(At, 0, 1); PG8_STAGE(PG8_SB(0, 0), b2, voffB); PG8_STAGE(PG8_SB(0, 1), b2 + hstepB, voffB); PG8_STAGE(PG8_SA(0, 0), a2, voffA);
            PG8_WAIT_V(8); PG8_WAIT_L(0); PG8_BAR; PG8_MMA(1, 0, At, B0); PG8_MMA(1, 1, At, B1); PG8_BAR; PG8_SCHED;
            PG8_LDB(B0, 1, 0); PG8_LDB(B1, 1, 1); PG8_SCHED; PG8_LDA(At, 1, 0); PG8_STAGE(PG8_SA(0, 1), a2 + hstepA, voffA);
            PG8_WAIT_V(8); PG8_WAIT_L(0); PG8_BAR; PG8_MMA(0, 0, At, B0); PG8_MMA(0, 1, At, B1); PG8_BAR; PG8_SCHED;
            PG8_LDA(At, 1, 1); PG8_STAGE(PG8_SB(1, 0), b3, voffB); PG8_STAGE(PG8_SB(1, 1), b3 + hstepB, voffB); PG8_STAGE(PG8_SA(1, 0), a3, voffA);
            PG8_WAIT_V(8); PG8_WAIT_L(0); PG8_BAR; PG8_MMA(1, 0, At, B0); PG8_MMA(1, 1, At, B1); PG8_BAR; PG8_SCHED;
        }
        if constexpr (ALIGN_EPI) { if (wr == 0) PG8_BAR; }
        E(acc, cur, wr, wc, fr, fq);
        if (!has_next) break;
#pragma unroll
        for (int a = 0; a < 2; ++a)
#pragma unroll
            for (int b = 0; b < 2; ++b)
#pragma unroll
                for (int m = 0; m < 4; ++m)
#pragma unroll
                    for (int n = 0; n < 2; ++n) acc[a][b][m][n] = (f32x4){0.f, 0.f, 0.f, 0.f};
        cur = nxt; cA = nA; cB = nB; ++ui;
        if constexpr (ALIGN_EPI) { if (wr == 1) PG8_BAR; }
    }
    PG8_WAIT_V(0);
    if constexpr (!ALIGN_EPI) { if (wr == 0) PG8_BAR; }
    PG8_BAR;
#undef PG8_SA
#undef PG8_SB
#undef PG8_STAGE
#undef PG8_LDA
#undef PG8_LDB
#undef PG8_MMA
#undef PG8_WAIT_V
#undef PG8_WAIT_L
#undef PG8_BAR
#undef PG8_SCHED
}
}

struct EpiStore {
    bf16_t* O; int ldc; int scale_cols; float s0; const float* rowscale; float rs_mul; const float* ropec; const float* ropes;
    __device__ __forceinline__ void operator()(const f32x4 (&acc)[2][2][4][2], const pg8::Unit& u, int wr, int wc, int fr, int fq) const {
        const int row0 = u.pm * 256 + wr * 64 + fr;
#pragma unroll
        for (int bj = 0; bj < 2; ++bj) {
            const int colg = u.pn * 256 + bj * 128 + wc * 32, col0 = colg + 8 * fq;
            const float sc = (colg < scale_cols) ? s0 : 1.0f;
            const bool rope = (ropec != nullptr) && (((colg >> 5) % 3) == 2);
#pragma unroll
            for (int ai = 0; ai < 2; ++ai)
#pragma unroll
                for (int m = 0; m < 4; ++m) {
                    const int row = row0 + ai * 128 + m * 16;
                    float f = sc; if (rowscale) f *= rowscale[row] * rs_mul;
                    f32x4 v0 = acc[ai][bj][m][0] * f, v1 = acc[ai][bj][m][1] * f;
                    if (rope) {
                        const int pos = row & (SEQ - 1), i0 = (8 * fq) & 15;
                        const f32x4 c0 = *(const f32x4*)(ropec + pos * 16 + i0), c1 = *(const f32x4*)(ropec + pos * 16 + i0 + 4);
                        const f32x4 s0v = *(const f32x4*)(ropes + pos * 16 + i0), s1v = *(const f32x4*)(ropes + pos * 16 + i0 + 4);
                        f32x4 p0, p1;
#pragma unroll
                        for (int e = 0; e < 4; ++e) { p0[e] = shflx(v0[e], 32, fq * 16 + fr); p1[e] = shflx(v1[e], 32, fq * 16 + fr); }
                        if (fq < 2) { v0 = v0 * c0 - p0 * s0v; v1 = v1 * c1 - p1 * s1v; }
                        else { v0 = p0 * s0v + v0 * c0; v1 = p1 * s1v + v1 * c1; }
                    }
                    u32x4 w; w.x = cvt_pk_bf16(v0[0], v0[1]); w.y = cvt_pk_bf16(v0[2], v0[3]); w.z = cvt_pk_bf16(v1[0], v1[1]); w.w = cvt_pk_bf16(v1[2], v1[3]);
                    *(u32x4*)(O + (size_t)row * ldc + col0) = w;
                }
        }
    }
};

__device__ __forceinline__ float dpp_ror1(float v) { return __int_as_float(__builtin_amdgcn_update_dpp(0, __float_as_int(v), 0x121, 0xf, 0xf, false)); }
__device__ __forceinline__ float dpp_ror2(float v) { return __int_as_float(__builtin_amdgcn_update_dpp(0, __float_as_int(v), 0x122, 0xf, 0xf, false)); }

struct EpiConv {
    bf16_t* act; const float* cw; const float* cb; float* halo; float* part; float* val01;
    __device__ __forceinline__ void operator()(const f32x4 (&acc)[2][2][4][2], const pg8::Unit& u, int wr, int wc, int fr, int fq) const {
        const int colb = u.pn * 128 + wc * 32 + 8 * fq;
        f32x4 w0[2], w1[2], w2[2], bb[2];
#pragma unroll
        for (int n = 0; n < 2; ++n) { const int col = colb + 4 * n;
            w0[n] = *(const f32x4*)(cw + col); w1[n] = *(const f32x4*)(cw + D_FF + col); w2[n] = *(const f32x4*)(cw + 2 * D_FF + col); bb[n] = *(const f32x4*)(cb + col); }
#pragma unroll
        for (int ai = 0; ai < 2; ++ai) {
            const int chunk = u.pm * 4 + ai * 2 + wr;
            f32x4 gprev[2]; gprev[0] = (f32x4){0.f, 0.f, 0.f, 0.f}; gprev[1] = gprev[0];
#pragma unroll
            for (int m = 0; m < 4; ++m) {
                const int row = u.pm * 256 + ai * 128 + wr * 64 + m * 16 + fr;
                u32x4 wq;
#pragma unroll
                for (int n = 0; n < 2; ++n) {
                    const int col = colb + 4 * n;
                    const f32x4 g = acc[ai][0][m][n], v = acc[ai][1][m][n];
                    f32x4 cv, o;
#pragma unroll
                    for (int e = 0; e < 4; ++e) {
                        const float h1 = (fr == 15) ? gprev[n][e] : g[e], h2 = (fr >= 14) ? gprev[n][e] : g[e];
                        const float p1 = dpp_ror1(h1), p2 = dpp_ror2(h2);
                        cv[e] = bb[n][e] + w2[n][e] * g[e] + w1[n][e] * p1 + w0[n][e] * p2;
                        const float x = cv[e], t = x * x * (-0.10294324f) + (-2.302208198f);
                        const float ex = __builtin_amdgcn_exp2f(x * t);
                        o[e] = (x * v[e]) * __builtin_amdgcn_rcpf(1.0f + ex);
                    }
                    if (m == 0 && fr < 2) { *(f32x4*)(part + (size_t)(chunk * 2 + fr) * D_FF + col) = cv; *(f32x4*)(val01 + (size_t)(chunk * 2 + fr) * D_FF + col) = v; }
                    if (m == 3 && fr >= 14) { *(f32x4*)(halo + (size_t)(chunk * 2 + fr - 14) * D_FF + col) = g; }
                    if (n == 0) { wq.x = cvt_pk_bf16(o[0], o[1]); wq.y = cvt_pk_bf16(o[2], o[3]); } else { wq.z = cvt_pk_bf16(o[0], o[1]); wq.w = cvt_pk_bf16(o[2], o[3]); }
                    gprev[n] = g;
                }
                *(u32x4*)(act + (size_t)row * D_FF + colb) = wq;
            }
        }
    }
};

struct AttnP {
    const bf16_t* Q; int ldq;
    const bf16_t* K1; int ldk1;
    const bf16_t* K2;
    const bf16_t* V; int ldv;
    bf16_t* O; int ldo;
    const float* bias;
    float sl2;
    const bf16_t* Oprev;
    const float* subln; float lam, osc;
};


__device__ __forceinline__ float max3f(float a, float b, float c) { float r; asm("v_max3_f32 %0, %1, %2, %3" : "=v"(r) : "v"(a), "v"(b), "v"(c)); return r; }
__device__ __forceinline__ float fadd_s(float a, float b) { float r; asm("v_add_f32_e32 %0, %1, %2" : "=v"(r) : "v"(a), "v"(b)); return r; }
__device__ __forceinline__ float fsub_s(float a, float b) { float r; asm("v_sub_f32_e32 %0, %1, %2" : "=v"(r) : "v"(a), "v"(b)); return r; }
__device__ __forceinline__ int crow(int r, int hi) { return (r & 3) + 8 * (r >> 2) + 4 * hi; }

template <int DQK, int DV, int MODE>
__device__ __forceinline__ void attn_unit(LAS unsigned char* lds, const AttnP& P, size_t rowbase, int qb, const int tid, const int pm) {
    constexpr int KST = DQK * 2 + 16, VST = (DV == 64) ? 192 : 320;
    constexpr int KBYTES = 64 * KST, VBYTES = 64 * VST, BUF = KBYTES + VBYTES + 256;
    constexpr int NKS = DQK / 16, NDB = DV / 32;
    const int lane = tid & 63, wid = __builtin_amdgcn_readfirstlane(tid >> 6), r32 = lane & 31, hi = lane >> 5;
    const int q0 = qb * 256, NT = 4 * qb + 4, ktlast = 4 * qb + (wid >> 1);
    const int qpos = q0 + wid * 32 + r32;
    bf16x8 qf[NKS];
    {
        const bf16_t* qrow = P.Q + (rowbase + qpos) * (size_t)P.ldq + hi * 8;
#pragma unroll
        for (int ks = 0; ks < NKS; ++ks) qf[ks] = *(const bf16x8*)(qrow + ks * 16);
    }
    float cq2 = 0.f;
    if (MODE == 0) cq2 = P.bias[qpos];
    float sdiag = 0.f;
    {
        const bf16_t* kd = P.K1 + (rowbase + qpos) * (size_t)P.ldk1 + hi * 8;
#pragma unroll
        for (int ks = 0; ks < NKS; ++ks) {
            const u32x4 kv_ = (MODE == 1 && ks >= 4) ? *(const u32x4*)(P.K2 + (rowbase + qpos) * 32 + (ks - 4) * 16 + hi * 8) : *(const u32x4*)(kd + ks * 16);
            const u32x4 qv_ = __builtin_bit_cast(u32x4, qf[ks]);
            sdiag += bf_lo(qv_.x) * bf_lo(kv_.x) + bf_hi(qv_.x) * bf_hi(kv_.x) + bf_lo(qv_.y) * bf_lo(kv_.y) + bf_hi(qv_.y) * bf_hi(kv_.y)
                   + bf_lo(qv_.z) * bf_lo(kv_.z) + bf_hi(qv_.z) * bf_hi(kv_.z) + bf_lo(qv_.w) * bf_lo(kv_.w) + bf_hi(qv_.w) * bf_hi(kv_.w);
        }
        auto rr_ = __builtin_amdgcn_permlane32_swap(__float_as_uint(sdiag), __float_as_uint(sdiag), false, false);
        sdiag = __uint_as_float(rr_[0]) + __uint_as_float(rr_[1]);
    }
    u32x4 kA0, kA1, vA0, vA1, kB0, kB1, vB0, vB1; float bA = 0.f, bB = 0.f;
    kA1 = (u32x4){0, 0, 0, 0}; vA1 = kA1; kB1 = kA1; vB1 = kA1;
    const int krow = tid >> 3, kch = tid & 7, k2row = tid >> 2, k2ch = tid & 3;
    const int vrow = (DV == 64) ? (tid >> 3) : (tid >> 4), vch = (DV == 64) ? (tid & 7) : (tid & 15);
    const unsigned koff = (unsigned)(krow * P.ldk1 + kch * 8), k2off = (unsigned)(k2row * 32 + k2ch * 8), voff0 = (unsigned)(vrow * P.ldv + vch * 8), voff1 = voff0 + 32u * (unsigned)P.ldv;
#define ATT_LOAD(X, kt) do { const size_t tr0 = rowbase + (size_t)(kt) * 64; \
        const bf16_t* kb_u = P.K1 + tr0 * P.ldk1; const bf16_t* vb_u = P.V + tr0 * P.ldv; \
        k##X##0 = *(const u32x4*)(kb_u + koff); \
        if (MODE == 1) { const bf16_t* k2_u = P.K2 + tr0 * 32; if (tid < 256) k##X##1 = *(const u32x4*)(k2_u + k2off); } \
        v##X##0 = *(const u32x4*)(vb_u + voff0); \
        if (DV == 128) v##X##1 = *(const u32x4*)(vb_u + voff1); \
        if (MODE == 0) { const float* b_u = P.bias + (kt) * 64; if (tid < 64) b##X = b_u[(unsigned)tid]; } } while (0)
#define ATT_STORE(X, buf) do { LAS unsigned char* bb_ = lds + (buf) * BUF; \
        *(LAS u32x4*)(bb_ + krow * KST + kch * 16) = k##X##0; \
        if (MODE == 1) { if (tid < 256) *(LAS u32x4*)(bb_ + k2row * KST + (8 + k2ch) * 16) = k##X##1; } \
        *(LAS u32x4*)(bb_ + KBYTES + vrow * VST + vch * 16) = v##X##0; \
        if (DV == 128) *(LAS u32x4*)(bb_ + KBYTES + (vrow + 32) * VST + vch * 16) = v##X##1; \
        if (MODE == 0) { if (tid < 64) *(LAS float*)(bb_ + KBYTES + VBYTES + tid * 4) = b##X; } } while (0)

    f32x16 o[NDB];
#pragma unroll
    for (int db = 0; db < NDB; ++db)
#pragma unroll
        for (int r = 0; r < 16; ++r) o[db][r] = 0.f;
    float mref = sdiag, lrun = 0.f;

    bf16x8 kf[2 * NKS];
#define ATT_READV(dst, db) do { _Pragma("unroll") for (int s_ = 0; s_ < 4; ++s_) { \
        const s16x4 t1 = __builtin_amdgcn_ds_read_tr16_b64_v4i16((LAS s16x4*)(vlane + (16 * s_) * VST + (db) * 64)); \
        const s16x4 t2 = __builtin_amdgcn_ds_read_tr16_b64_v4i16((LAS s16x4*)(vlane + (16 * s_ + 8) * VST + (db) * 64)); \
        dst[s_] = (bf16x8){t1[0], t1[1], t1[2], t1[3], t2[0], t2[1], t2[2], t2[3]}; } } while (0)
#define ATT_COMPUTE(kt, cb, RDK, PFK) do { \
            LAS unsigned char* kb = lds + (cb) * BUF; \
            LAS unsigned char* vb = kb + KBYTES; \
            bf16x8 kfl_[2 * NKS]; bf16x8 (&kfr)[2 * NKS] = *((MODE == 0) ? &kf : &kfl_); \
            f32x16 s0, s1; \
            if (MODE == 0) { \
                LAS unsigned char* bp = vb + VBYTES; const float cqm = cq2 - mref; \
                _Pragma("unroll") for (int a = 0; a < 4; ++a) { \
                    const f32x4 c0 = *(LAS f32x4*)(bp + (8 * a + 4 * hi) * 4), c1 = *(LAS f32x4*)(bp + (32 + 8 * a + 4 * hi) * 4); \
                    _Pragma("unroll") for (int e = 0; e < 4; ++e) { s0[4 * a + e] = fsub_s(cqm, c0[e]); s1[4 * a + e] = fsub_s(cqm, c1[e]); } } \
            } else if (MODE == 2) { \
                const float c0 = P.sl2 * (float)((kt) * 64 + 4 * hi - qpos) - mref; \
                const float c32 = 32.0f * P.sl2; _Pragma("unroll") for (int r = 0; r < 16; ++r) { s0[r] = fadd_s(c0, P.sl2 * (float)((r & 3) + 8 * (r >> 2))); s1[r] = fadd_s(s0[r], c32); } \
            } else { \
                _Pragma("unroll") for (int r = 0; r < 16; ++r) { s0[r] = -mref; s1[r] = -mref; } \
            } \
            { if (RDK) { _Pragma("unroll") for (int ks = 0; ks < NKS; ++ks) { \
                kfr[2 * ks] = *(LAS bf16x8*)(kb + r32 * KST + ks * 32 + hi * 16); \
                kfr[2 * ks + 1] = *(LAS bf16x8*)(kb + (r32 + 32) * KST + ks * 32 + hi * 16); } } \
              if (DV == 64) __builtin_amdgcn_sched_barrier(0); \
              __builtin_amdgcn_s_setprio(1); \
              _Pragma("unroll") for (int ks = 0; ks < NKS; ++ks) { \
                s0 = __builtin_amdgcn_mfma_f32_32x32x16_bf16(kfr[2 * ks], qf[ks], s0, 0, 0, 0); \
                s1 = __builtin_amdgcn_mfma_f32_32x32x16_bf16(kfr[2 * ks + 1], qf[ks], s1, 0, 0, 0); } \
              __builtin_amdgcn_s_setprio(0); \
              if (PFK) { LAS unsigned char* kn_ = kb + BUF; _Pragma("unroll") for (int ks = 0; ks < NKS; ++ks) { \
                kfr[2 * ks] = *(LAS bf16x8*)(kn_ + r32 * KST + ks * 32 + hi * 16); \
                kfr[2 * ks + 1] = *(LAS bf16x8*)(kn_ + (r32 + 32) * KST + ks * 32 + hi * 16); } } } \
            LAS unsigned char* vlane = vb + (4 * hi + ((lane & 15) >> 2)) * VST + (16 * ((lane >> 4) & 1) + 4 * (lane & 3)) * 2; \
            bf16x8 vf[2][4]; \
            { ATT_READV(vf[0], 0); } \
            __builtin_amdgcn_sched_barrier(0); \
            if ((kt) == ktlast) { \
                const int kbase = (kt) * 64 + 4 * hi; \
                _Pragma("unroll") for (int r = 0; r < 16; ++r) { const int key = kbase + (r & 3) + 8 * (r >> 2); if (key > qpos) s0[r] = NEGBIG; if (key + 32 > qpos) s1[r] = NEGBIG; } } \
            float mx = max3f(s0[0], s1[0], s0[1]), mx2 = max3f(s1[1], s0[2], s1[2]); \
            _Pragma("unroll") for (int r = 3; r < 15; r += 2) { mx = max3f(mx, s0[r], s1[r]); mx2 = max3f(mx2, s0[r + 1], s1[r + 1]); } \
            mx = max3f(mx, s0[15], s1[15]); mx = max3f(mx, mx2, mx2); \
            if (__any(mx > 64.0f)) { \
                { auto rr_ = __builtin_amdgcn_permlane32_swap(__float_as_uint(mx), __float_as_uint(mx), false, false); mx = fmaxf(__uint_as_float(rr_[0]), __uint_as_float(rr_[1])); } \
                const float dl = fmaxf(mx, 0.f); \
                const float alpha = __builtin_amdgcn_exp2f(-dl); \
                mref += dl; lrun *= alpha; \
                _Pragma("unroll") for (int r = 0; r < 16; ++r) { s0[r] -= dl; s1[r] -= dl; } \
                _Pragma("unroll") for (int db = 0; db < NDB; ++db) _Pragma("unroll") for (int r = 0; r < 16; ++r) o[db][r] *= alpha; } \
            float ls = 0.f, ls2 = 0.f; \
            _Pragma("unroll") for (int r = 0; r < 16; ++r) { s0[r] = __builtin_amdgcn_exp2f(s0[r]); s1[r] = __builtin_amdgcn_exp2f(s1[r]); ls = fadd_s(ls, s0[r]); ls2 = fadd_s(ls2, s1[r]); } \
            lrun += fadd_s(ls, ls2); \
            u32x4 pw[4]; \
            pw[0] = (u32x4){cvt_pk_bf16(s0[0], s0[1]), cvt_pk_bf16(s0[2], s0[3]), cvt_pk_bf16(s0[4], s0[5]), cvt_pk_bf16(s0[6], s0[7])}; \
            pw[1] = (u32x4){cvt_pk_bf16(s0[8], s0[9]), cvt_pk_bf16(s0[10], s0[11]), cvt_pk_bf16(s0[12], s0[13]), cvt_pk_bf16(s0[14], s0[15])}; \
            pw[2] = (u32x4){cvt_pk_bf16(s1[0], s1[1]), cvt_pk_bf16(s1[2], s1[3]), cvt_pk_bf16(s1[4], s1[5]), cvt_pk_bf16(s1[6], s1[7])}; \
            pw[3] = (u32x4){cvt_pk_bf16(s1[8], s1[9]), cvt_pk_bf16(s1[10], s1[11]), cvt_pk_bf16(s1[12], s1[13]), cvt_pk_bf16(s1[14], s1[15])}; \
            \
            _Pragma("unroll") for (int db = 0; db < NDB; ++db) { \
                if (db + 1 < NDB) ATT_READV(vf[(db + 1) & 1], db + 1); \
                __builtin_amdgcn_sched_barrier(0); \
                __builtin_amdgcn_s_setprio(1); \
                _Pragma("unroll") for (int s = 0; s < 4; ++s) \
                    o[db] = __builtin_amdgcn_mfma_f32_32x32x16_bf16(vf[db & 1][s], __builtin_bit_cast(bf16x8, pw[s]), o[db], 0, 0, 0); \
                __builtin_amdgcn_s_setprio(0); \
                __builtin_amdgcn_sched_barrier(0); } \
        } while (0)

#define ATT_BAR() do { asm volatile("s_waitcnt lgkmcnt(0)" ::: "memory"); __builtin_amdgcn_s_barrier(); asm volatile("" ::: "memory"); } while (0)
    ATT_LOAD(A, 0); ATT_LOAD(B, 1);
    ATT_STORE(A, 0); ATT_STORE(B, 1);
    ATT_LOAD(A, 2); ATT_LOAD(B, 3);
    ATT_BAR();
    for (int kt = 0; kt < NT; kt += 2) {
        const int sb = (kt & 2);
        const bool two_ = (kt + 1 <= ktlast);
        if (kt <= ktlast && pm != 1) ATT_COMPUTE(kt, sb, true, (KPF2 && MODE == 0 && two_));
        if (two_ && pm != 1) ATT_COMPUTE(kt + 1, sb + 1, !(KPF2 && MODE == 0), false);
        if (kt + 2 < NT && pm < 2) { ATT_STORE(A, sb ^ 2); ATT_STORE(B, (sb ^ 2) + 1); }
        if (pm != 3) ATT_BAR();
        if (kt + 4 < NT && pm < 2) { ATT_LOAD(A, kt + 4); ATT_LOAD(B, kt + 5); }
    }
    ATT_BAR();
    float ltot; { auto rr_ = __builtin_amdgcn_permlane32_swap(__float_as_uint(lrun), __float_as_uint(lrun), false, false); ltot = __uint_as_float(rr_[0]) + __uint_as_float(rr_[1]); }
    const float inv = 1.0f / ltot;
    int qpe_ = qpos; asm volatile("" : "+v"(qpe_));
    bf16_t* orow = P.O + (rowbase + qpe_) * (size_t)P.ldo + 8 * hi;
    if (MODE == 2 && P.Oprev != nullptr) {
        const bf16_t* prow = P.Oprev + (rowbase + qpe_) * (size_t)P.ldo + 8 * hi;
        f32x4 cv[NDB][2][2]; float ss = 0.f;
#pragma unroll
        for (int db = 0; db < NDB; ++db)
#pragma unroll
            for (int a = 0; a < 4; a += 2) {
                const unsigned x0 = cvt_pk_bf16(o[db][4 * a] * inv, o[db][4 * a + 1] * inv), x1 = cvt_pk_bf16(o[db][4 * a + 2] * inv, o[db][4 * a + 3] * inv);
                const unsigned y0 = cvt_pk_bf16(o[db][4 * a + 4] * inv, o[db][4 * a + 5] * inv), y1 = cvt_pk_bf16(o[db][4 * a + 6] * inv, o[db][4 * a + 7] * inv);
                const auto s0_ = __builtin_amdgcn_permlane32_swap(x0, y0, false, false);
                const auto s1_ = __builtin_amdgcn_permlane32_swap(x1, y1, false, false);
                const u32x4 w1 = *(const u32x4*)(prow + db * 32 + a * 8);
                const f32x4 d0 = (f32x4){bf_lo(w1.x) - P.lam * bf_lo(s0_[0]), bf_hi(w1.x) - P.lam * bf_hi(s0_[0]), bf_lo(w1.y) - P.lam * bf_lo(s1_[0]), bf_hi(w1.y) - P.lam * bf_hi(s1_[0])};
                const f32x4 d1 = (f32x4){bf_lo(w1.z) - P.lam * bf_lo(s0_[1]), bf_hi(w1.z) - P.lam * bf_hi(s0_[1]), bf_lo(w1.w) - P.lam * bf_lo(s1_[1]), bf_hi(w1.w) - P.lam * bf_hi(s1_[1])};
                cv[db][a >> 1][0] = d0; cv[db][a >> 1][1] = d1;
                ss += (d0[0] * d0[0] + d0[1] * d0[1]) + (d0[2] * d0[2] + d0[3] * d0[3]) + (d1[0] * d1[0] + d1[1] * d1[1]) + (d1[2] * d1[2] + d1[3] * d1[3]);
            }
        { auto rr_ = __builtin_amdgcn_permlane32_swap(__float_as_uint(ss), __float_as_uint(ss), false, false); ss = __uint_as_float(rr_[0]) + __uint_as_float(rr_[1]); }
        const float rs = rsqrtf(ss * (1.0f / 128.0f) + RMS_EPS) * P.osc;
        const float* sgp = P.subln + 8 * hi;
#pragma unroll
        for (int db = 0; db < NDB; ++db)
#pragma unroll
            for (int a = 0; a < 4; a += 2) {
                const f32x4 g0 = *(const f32x4*)(sgp + db * 32 + a * 8), g1 = *(const f32x4*)(sgp + db * 32 + a * 8 + 4);
                const f32x4 e0 = cv[db][a >> 1][0] * rs * g0, e1 = cv[db][a >> 1][1] * rs * g1;
                u32x4 w; w.x = cvt_pk_bf16(e0[0], e0[1]); w.y = cvt_pk_bf16(e0[2], e0[3]); w.z = cvt_pk_bf16(e1[0], e1[1]); w.w = cvt_pk_bf16(e1[2], e1[3]);
                *(u32x4*)(orow + db * 32 + a * 8) = w;
            }
    } else {
#pragma unroll
    for (int db = 0; db < NDB; ++db)
#pragma unroll
        for (int a = 0; a < 4; a += 2) {
            const unsigned x0 = cvt_pk_bf16(o[db][4 * a] * inv, o[db][4 * a + 1] * inv), x1 = cvt_pk_bf16(o[db][4 * a + 2] * inv, o[db][4 * a + 3] * inv);
            const unsigned y0 = cvt_pk_bf16(o[db][4 * a + 4] * inv, o[db][4 * a + 5] * inv), y1 = cvt_pk_bf16(o[db][4 * a + 6] * inv, o[db][4 * a + 7] * inv);
            const auto s0_ = __builtin_amdgcn_permlane32_swap(x0, y0, false, false);
            const auto s1_ = __builtin_amdgcn_permlane32_swap(x1, y1, false, false);
            u32x4 w; w.x = s0_[0]; w.y = s1_[0]; w.z = s0_[1]; w.w = s1_[1];
            *(u32x4*)(orow + db * 32 + a * 8) = w;
        }
    }
#undef ATT_COMPUTE
#undef ATT_READV
#undef ATT_BAR
#undef ATT_LOAD
#undef ATT_STORE
}


#define XB_TMO      128
#define XB_XCNT(j)  (256  + 64 * (j))
#define XB_XSUB(j)  (1280 + 64 * (j))
#define XB_XGEN(j)  (2304 + 64 * (j))
#define XB_TOP      3328
#define XB_TOPGEN   3392
#define XCD_BAR_WORDS 3456
#define XB_SPIN_CAP (1u << 18)

__device__ __forceinline__ unsigned xb_ld(unsigned* p)              { return __hip_atomic_load(p, __ATOMIC_RELAXED, __HIP_MEMORY_SCOPE_AGENT); }
__device__ __forceinline__ unsigned xb_add(unsigned* p, unsigned v) { return __hip_atomic_fetch_add(p, v, __ATOMIC_RELAXED, __HIP_MEMORY_SCOPE_AGENT); }
__device__ __forceinline__ unsigned xb_xcc_id() { return (unsigned)__builtin_amdgcn_s_getreg((3 << 11) | 20) & 0xFu; }
#define XB_SPIN(cond, bar) do { unsigned _sp = 0; while (cond) { __builtin_amdgcn_s_sleep(1); \
    if ((++_sp & 255u) == 0u) { if (xb_ld(&(bar)[XB_TMO])) break; if (_sp > XB_SPIN_CAP) { atomicAdd(&(bar)[XB_TMO], 1u); break; } } } } while (0)

struct XcdBarrier { unsigned* bar; unsigned x; volatile LAS unsigned* st; };
__device__ __forceinline__ XcdBarrier xcd_barrier_post(unsigned* bar, volatile LAS unsigned* st) {
    XcdBarrier b; b.bar = bar; b.x = xb_xcc_id(); b.st = st;
    if (threadIdx.x == 0) { const unsigned r_ = xb_add(&bar[XB_XCNT(b.x)], 1u); st[2] = r_; }
    return b;
}
__device__ __forceinline__ void xcd_barrier_complete(unsigned* bar, unsigned x, unsigned& nloc, unsigned& nx) {
    const unsigned G = gridDim.x * gridDim.y * gridDim.z;
    unsigned sum, cnt, mine, sp = 0u;
    for (;;) {
        sum = 0u; cnt = 0u; mine = 0u;
#pragma unroll
        for (unsigned j = 0; j < 16; ++j) { const unsigned c = xb_ld(&bar[XB_XCNT(j)]); sum += c; cnt += (c > 0u) ? 1u : 0u; mine = (j == x) ? c : mine; }
        if (sum == G) break;
        __builtin_amdgcn_s_sleep(1);
        if ((++sp & 255u) == 0u) { if (xb_ld(&bar[XB_TMO])) break; if (sp > XB_SPIN_CAP) { atomicAdd(&bar[XB_TMO], 1u); break; } }
    }
    nloc = mine > 0u ? mine : 1u; nx = cnt > 0u ? cnt : 1u;
}

__device__ __forceinline__ void xcd_barrier(const XcdBarrier& b) {
    asm volatile("s_waitcnt vmcnt(0)" ::: "memory");
    __syncthreads();
    if (threadIdx.x == 0) {
        unsigned* bar = b.bar;
        __builtin_amdgcn_s_waitcnt(0);
        unsigned nloc = b.st[0], nx = b.st[1];
        if (nloc == 0u) { xcd_barrier_complete(bar, b.x, nloc, nx); b.st[0] = nloc; b.st[1] = nx; }
        const unsigned old = xb_add(&bar[XB_XSUB(b.x)], 1u);
        const unsigned gen = old / nloc;
        if (old + 1u == (gen + 1u) * nloc) {
            __builtin_amdgcn_fence(__ATOMIC_RELEASE, "agent");
            asm volatile("s_waitcnt vmcnt(0)" ::: "memory");
            const unsigned og = xb_add(&bar[XB_TOP], 1u);
            const unsigned tg = og / nx;
            if (og + 1u == (tg + 1u) * nx) xb_add(&bar[XB_TOPGEN], 1u);
            else XB_SPIN(xb_ld(&bar[XB_TOPGEN]) == tg, bar);
            __builtin_amdgcn_fence(__ATOMIC_ACQUIRE, "agent");
            xb_add(&bar[XB_XGEN(b.x)], 1u);
            asm volatile("s_waitcnt vmcnt(0)" ::: "memory");
        } else {
            XB_SPIN(xb_ld(&bar[XB_XGEN(b.x)]) == gen, bar);
            __builtin_amdgcn_fence(__ATOMIC_ACQUIRE, "agent");
            asm volatile("s_waitcnt vmcnt(0)" ::: "memory");
        }
    }
    __syncthreads();
}

struct Params { const float* in[23]; float* out; unsigned char* ws; int ph_lo, ph_hi, coop, pad; };

struct Frame {
    LAS unsigned char* lds;
    int tid, lane, wave, vcu, G, gw, NGW, bx;
    unsigned char* ws; bf16_t* hnbuf;
    int r0, rstep, rend, xcd, rank;
};

__device__ __forceinline__ void transpose_item(const float* W, int K, int Nsrc, bf16_t* WT, int dst_n0, int src_n0, int nvalid, const float* kgain, int k0, LAS float* scr, int lane) {
    const int srcn = src_n0 + (lane & 31);
#pragma unroll 32
    for (int i = 0; i < 32; ++i) { const int kk = 2 * i + (lane >> 5);
        float v = (srcn < nvalid) ? W[(size_t)(k0 + kk) * Nsrc + srcn] : 0.f;
        if (kgain) v *= kgain[k0 + kk];
        scr[kk * 33 + (lane & 31)] = v; }
    asm volatile("s_waitcnt lgkmcnt(0)" ::: "memory");
    const int c = lane & 7;
#pragma unroll
    for (int j = 0; j < 4; ++j) { const int n = (lane >> 3) + 8 * j; const LAS float* s = scr + (8 * c) * 33 + n;
        u32x4 o; o.x = cvt_pk_bf16(s[0 * 33], s[1 * 33]); o.y = cvt_pk_bf16(s[2 * 33], s[3 * 33]); o.z = cvt_pk_bf16(s[4 * 33], s[5 * 33]); o.w = cvt_pk_bf16(s[6 * 33], s[7 * 33]);
        *(u32x4*)(WT + (size_t)(dst_n0 + n) * K + k0 + 8 * c) = o; }
    asm volatile("s_waitcnt lgkmcnt(0)" ::: "memory");
}

__device__ __forceinline__ void convert_group(const Frame& F, const float* W, int nl, int K, int Nsrc, int Ndst, bf16_t* WT, int kind, const float* kgain, int gain_stride) {
    int tl_ = F.tid; asm volatile("" : "+v"(tl_)); const int lane_l = tl_ & 63;
    LAS float* scr = (LAS float*)(F.lds + F.wave * 16384);
    const int nblk = Ndst / 32, per = (K / 64) * nblk, total = nl * per;
    for (int it = F.gw; it < total; it += F.NGW) {
        const int l = it / per, r = it % per, kb = r / nblk, nb = r % nblk, dn0 = nb * 32;
        int sn0 = dn0;
        if (kind == 1) { const int j = dn0 >> 8, i0 = dn0 & 255; sn0 = (i0 < 128) ? (128 * j + i0) : (D_FF + 128 * j + i0 - 128); }
        transpose_item(W + (size_t)l * K * Nsrc, K, Nsrc, WT + (size_t)l * Ndst * K, dn0, sn0, Nsrc, kgain ? kgain + l * gain_stride : nullptr, kb * 64, scr, lane_l);
    }
}

__device__ __forceinline__ void phase_prologue(const Frame& F, const Params& p) {
    int tl_ = F.tid; asm volatile("" : "+v"(tl_)); const int lane_l = tl_ & 63;
    bf16_t* WB = (bf16_t*)(F.ws + WS_W);
    convert_group(F, p.in[5], 2, 1024, EIN_N, EIN_NP, WB + OW_EIN, 0, nullptr, 0);
    convert_group(F, p.in[8], 2, 384, 768, 768, WB + OW_EUQ, 0, p.in[7], 384);
    convert_group(F, p.in[10], 2, 256, 1024, 1024, WB + OW_EUKV, 0, p.in[9], 256);
    convert_group(F, p.in[11], 2, 1024, 1024, 1024, WB + OW_EOUT, 0, nullptr, 0);
    convert_group(F, p.in[12], 2, 1024, OIN_N, OIN_N, WB + OW_OIN, 0, nullptr, 0);
    convert_group(F, p.in[18], 2, 1024, 1024, 1024, WB + OW_OOUT, 0, nullptr, 0);
    convert_group(F, p.in[19], 4, 1024, 2 * D_FF, 2 * D_FF, WB + OW_UP, 1, nullptr, 0);
    convert_group(F, p.in[22], 4, D_FF, 1024, 1024, WB + OW_DN, 0, nullptr, 0);
    float* cosT = (float*)(F.ws + WS_COS); float* sinT = (float*)(F.ws + WS_SIN);
    for (int e = F.bx * NTHREADS + F.tid; e < SEQ * 16; e += F.G * NTHREADS) {
        const int pos = e >> 4, i = e & 15;
        const float inv = exp2f(-(float)i * 0.8304820237218406f);
        const float ang = (float)pos * inv;
        const float kq = rintf(ang * 0.6366197723675814f);
        float r = fmaf(-kq, 1.5703125f, ang); r = fmaf(-kq, 4.837512969970703125e-4f, r); r = fmaf(-kq, 7.54978995489188216e-8f, r);
        const float r2_ = r * r;
        const float sn = r + r * r2_ * (-1.6666666667e-1f + r2_ * (8.3333333333e-3f + r2_ * (-1.9841269841e-4f + r2_ * 2.7557319224e-6f)));
        const float cs = 1.0f + r2_ * (-0.5f + r2_ * (4.1666666667e-2f + r2_ * (-1.3888888889e-3f + r2_ * (2.4801587302e-5f + r2_ * -2.7557319224e-7f))));
        const int q4 = ((int)kq) & 3;
        const float s_ = (q4 == 0) ? sn : (q4 == 1) ? cs : (q4 == 2) ? -sn : -cs;
        const float c_ = (q4 == 0) ? cs : (q4 == 1) ? -sn : (q4 == 2) ? -cs : sn;
        cosT[e] = c_; sinT[e] = s_;
    }
    const float* x = p.in[0]; const float* g = p.in[1]; bf16_t* hn = F.hnbuf;
    f32x4 gg[4]; gg[0] = *(const f32x4*)(g + 8 * lane_l); gg[1] = *(const f32x4*)(g + 8 * lane_l + 4); gg[2] = *(const f32x4*)(g + 512 + 8 * lane_l); gg[3] = *(const f32x4*)(g + 512 + 8 * lane_l + 4);
    for (int row = F.r0; row < F.rend; row += 2 * F.rstep) {
        f32x4 v[2][4]; float ss[2];
#pragma unroll
        for (int q = 0; q < 2; ++q) { const float* xr = x + (size_t)(row + q * F.rstep) * 1024;
            v[q][0] = *(const f32x4*)(xr + 8 * lane_l); v[q][1] = *(const f32x4*)(xr + 8 * lane_l + 4); v[q][2] = *(const f32x4*)(xr + 512 + 8 * lane_l); v[q][3] = *(const f32x4*)(xr + 512 + 8 * lane_l + 4); }
#pragma unroll
        for (int q = 0; q < 2; ++q) { ss[q] = 0.f;
#pragma unroll
            for (int j = 0; j < 4; ++j) ss[q] += v[q][j][0] * v[q][j][0] + v[q][j][1] * v[q][j][1] + v[q][j][2] * v[q][j][2] + v[q][j][3] * v[q][j][3]; }
#pragma unroll
        for (int o = 1; o < 64; o <<= 1) { ss[0] += shflx(ss[0], o, lane_l); ss[1] += shflx(ss[1], o, lane_l); }
#pragma unroll
        for (int q = 0; q < 2; ++q) {
            const float r = rsqrtf(ss[q] * (1.0f / 1024.0f) + RMS_EPS);
            f32x4 y[4];
#pragma unroll
            for (int j = 0; j < 4; ++j) y[j] = v[q][j] * r * gg[j];
            u32x4 w0, w1;
            w0.x = cvt_pk_bf16(y[0][0], y[0][1]); w0.y = cvt_pk_bf16(y[0][2], y[0][3]); w0.z = cvt_pk_bf16(y[1][0], y[1][1]); w0.w = cvt_pk_bf16(y[1][2], y[1][3]);
            w1.x = cvt_pk_bf16(y[2][0], y[2][1]); w1.y = cvt_pk_bf16(y[2][2], y[2][3]); w1.z = cvt_pk_bf16(y[3][0], y[3][1]); w1.w = cvt_pk_bf16(y[3][2], y[3][3]);
            const size_t ro = (size_t)(row + q * F.rstep) * 1024;
            *(u32x4*)(hn + ro + 8 * lane_l) = w0; *(u32x4*)(hn + ro + 512 + 8 * lane_l) = w1;
        }
    }
}

template <bool XIN_F32, bool XOUT_F32>
__device__ __forceinline__ void phase_rowpost(const Frame& F, const bf16_t* mb, const void* xin_, void* xout_, const float* gpost, const float* gnext, bf16_t* hn) {
    int tl_ = F.tid; asm volatile("" : "+v"(tl_)); const int lane_l = tl_ & 63;
    const int c0 = 8 * lane_l, c1 = 512 + 8 * lane_l;
    f32x4 gp[4]; gp[0] = *(const f32x4*)(gpost + c0); gp[1] = *(const f32x4*)(gpost + c0 + 4); gp[2] = *(const f32x4*)(gpost + c1); gp[3] = *(const f32x4*)(gpost + c1 + 4);
    f32x4 gn[4];
#pragma unroll
    for (int j = 0; j < 4; ++j) gn[j] = (f32x4){0.f, 0.f, 0.f, 0.f};
    if (gnext) { gn[0] = *(const f32x4*)(gnext + c0); gn[1] = *(const f32x4*)(gnext + c0 + 4); gn[2] = *(const f32x4*)(gnext + c1); gn[3] = *(const f32x4*)(gnext + c1 + 4); }
    for (int row = F.r0; row < F.rend; row += 2 * F.rstep) {
        size_t ro[2]; ro[0] = (size_t)row * 1024; ro[1] = (size_t)(row + F.rstep) * 1024;
        u32x4 m0[2], m1[2]; f32x4 xv[2][4];
#pragma unroll
        for (int q = 0; q < 2; ++q) {
            m0[q] = *(const u32x4*)(mb + ro[q] + c0); m1[q] = *(const u32x4*)(mb + ro[q] + c1);
            if (XIN_F32) { const float* xin = (const float*)xin_;
                xv[q][0] = *(const f32x4*)(xin + ro[q] + c0); xv[q][1] = *(const f32x4*)(xin + ro[q] + c0 + 4); xv[q][2] = *(const f32x4*)(xin + ro[q] + c1); xv[q][3] = *(const f32x4*)(xin + ro[q] + c1 + 4);
            } else { const bf16_t* xin = (const bf16_t*)xin_;
                const u32x4 a0 = *(const u32x4*)(xin + ro[q] + c0), a1 = *(const u32x4*)(xin + ro[q] + c1);
                xv[q][0] = (f32x4){bf_lo(a0.x), bf_hi(a0.x), bf_lo(a0.y), bf_hi(a0.y)}; xv[q][1] = (f32x4){bf_lo(a0.z), bf_hi(a0.z), bf_lo(a0.w), bf_hi(a0.w)};
                xv[q][2] = (f32x4){bf_lo(a1.x), bf_hi(a1.x), bf_lo(a1.y), bf_hi(a1.y)}; xv[q][3] = (f32x4){bf_lo(a1.z), bf_hi(a1.z), bf_lo(a1.w), bf_hi(a1.w)};
            }
        }
        f32x4 mv[2][4]; float ss[2];
#pragma unroll
        for (int q = 0; q < 2; ++q) {
            mv[q][0] = (f32x4){bf_lo(m0[q].x), bf_hi(m0[q].x), bf_lo(m0[q].y), bf_hi(m0[q].y)}; mv[q][1] = (f32x4){bf_lo(m0[q].z), bf_hi(m0[q].z), bf_lo(m0[q].w), bf_hi(m0[q].w)};
            mv[q][2] = (f32x4){bf_lo(m1[q].x), bf_hi(m1[q].x), bf_lo(m1[q].y), bf_hi(m1[q].y)}; mv[q][3] = (f32x4){bf_lo(m1[q].z), bf_hi(m1[q].z), bf_lo(m1[q].w), bf_hi(m1[q].w)};
            ss[q] = 0.f;
#pragma unroll
            for (int j = 0; j < 4; ++j) ss[q] += mv[q][j][0] * mv[q][j][0] + mv[q][j][1] * mv[q][j][1] + mv[q][j][2] * mv[q][j][2] + mv[q][j][3] * mv[q][j][3];
        }
#pragma unroll
        for (int o = 1; o < 64; o <<= 1) { ss[0] += shflx(ss[0], o, lane_l); ss[1] += shflx(ss[1], o, lane_l); }
        float s2[2];
#pragma unroll
        for (int q = 0; q < 2; ++q) {
            const float r1 = rsqrtf(ss[q] * (1.0f / 1024.0f) + RMS_EPS);
            s2[q] = 0.f;
#pragma unroll
            for (int j = 0; j < 4; ++j) { xv[q][j] = xv[q][j] + mv[q][j] * r1 * gp[j]; s2[q] += xv[q][j][0] * xv[q][j][0] + xv[q][j][1] * xv[q][j][1] + xv[q][j][2] * xv[q][j][2] + xv[q][j][3] * xv[q][j][3]; }
            if (XOUT_F32) { float* xout = (float*)xout_;
                *(f32x4*)(xout + ro[q] + c0) = xv[q][0]; *(f32x4*)(xout + ro[q] + c0 + 4) = xv[q][1]; *(f32x4*)(xout + ro[q] + c1) = xv[q][2]; *(f32x4*)(xout + ro[q] + c1 + 4) = xv[q][3];
            } else { bf16_t* xout = (bf16_t*)xout_; u32x4 w0, w1;
                w0.x = cvt_pk_bf16(xv[q][0][0], xv[q][0][1]); w0.y = cvt_pk_bf16(xv[q][0][2], xv[q][0][3]); w0.z = cvt_pk_bf16(xv[q][1][0], xv[q][1][1]); w0.w = cvt_pk_bf16(xv[q][1][2], xv[q][1][3]);
                w1.x = cvt_pk_bf16(xv[q][2][0], xv[q][2][1]); w1.y = cvt_pk_bf16(xv[q][2][2], xv[q][2][3]); w1.z = cvt_pk_bf16(xv[q][3][0], xv[q][3][1]); w1.w = cvt_pk_bf16(xv[q][3][2], xv[q][3][3]);
                *(u32x4*)(xout + ro[q] + c0) = w0; *(u32x4*)(xout + ro[q] + c1) = w1;
            }
        }
        if (gnext) {
#pragma unroll
            for (int o = 1; o < 64; o <<= 1) { s2[0] += shflx(s2[0], o, lane_l); s2[1] += shflx(s2[1], o, lane_l); }
#pragma unroll
            for (int q = 0; q < 2; ++q) {
                const float r2 = rsqrtf(s2[q] * (1.0f / 1024.0f) + RMS_EPS);
                f32x4 y[4];
#pragma unroll
                for (int j = 0; j < 4; ++j) y[j] = xv[q][j] * r2 * gn[j];
                u32x4 w0, w1;
                w0.x = cvt_pk_bf16(y[0][0], y[0][1]); w0.y = cvt_pk_bf16(y[0][2], y[0][3]); w0.z = cvt_pk_bf16(y[1][0], y[1][1]); w0.w = cvt_pk_bf16(y[1][2], y[1][3]);
                w1.x = cvt_pk_bf16(y[2][0], y[2][1]); w1.y = cvt_pk_bf16(y[2][2], y[2][3]); w1.z = cvt_pk_bf16(y[3][0], y[3][1]); w1.w = cvt_pk_bf16(y[3][2], y[3][3]);
                *(u32x4*)(hn + ro[q] + c0) = w0; *(u32x4*)(hn + ro[q] + c1) = w1;
            }
        }
    }
}

__device__ __forceinline__ float sumsq8(u32x4 v) {
    const float a = bf_lo(v.x), b = bf_hi(v.x), c = bf_lo(v.y), d = bf_hi(v.y), e = bf_lo(v.z), f = bf_hi(v.z), g = bf_lo(v.w), h = bf_hi(v.w);
    return (a * a + b * b) + (c * c + d * d) + (e * e + f * f) + (g * g + h * h);
}

__device__ __forceinline__ void phase_even_small(const Frame& F, const Params& p, int li) {
    int tl_ = F.tid; asm volatile("" : "+v"(tl_)); const int lane_l = tl_ & 63;
    const bf16_t* proj = (const bf16_t*)(F.ws + WS_PROJ);
    float* rq = (float*)(F.ws + WS_RSTDQ); float* rkv = (float*)(F.ws + WS_RSTDKV);
    bf16_t* krope = (bf16_t*)(F.ws + WS_KROPE);
    const float* cosT = (const float*)(F.ws + WS_COS); const float* sinT = (const float*)(F.ws + WS_SIN);
    for (int t0 = F.r0; t0 < F.rend; t0 += 4 * F.rstep) {
        u32x4 cq[4], ckv[4]; float x1[4], x2[4], cs[4], sn[4];
#pragma unroll
        for (int q = 0; q < 4; ++q) {
            const int t = t0 + q * F.rstep; const bf16_t* pr = proj + (size_t)t * EIN_NP;
            cq[q] = (u32x4){0, 0, 0, 0}; ckv[q] = (u32x4){0, 0, 0, 0}; x1[q] = 0.f; x2[q] = 0.f; cs[q] = 0.f; sn[q] = 0.f;
            if (lane_l < 48) cq[q] = *(const u32x4*)(pr + C_CQ + 8 * lane_l);
            if (lane_l < 32) ckv[q] = *(const u32x4*)(pr + C_CKV + 8 * lane_l);
            if (lane_l < 16) { x1[q] = bf2f(pr[C_KR + lane_l]); x2[q] = bf2f(pr[C_KR + 16 + lane_l]); const int pos = t & (SEQ - 1); cs[q] = cosT[pos * 16 + lane_l]; sn[q] = sinT[pos * 16 + lane_l]; }
        }
        float sq[4], skv[4];
#pragma unroll
        for (int q = 0; q < 4; ++q) { sq[q] = sumsq8(cq[q]); skv[q] = sumsq8(ckv[q]); }
#pragma unroll
        for (int o = 1; o < 64; o <<= 1) {
#pragma unroll
            for (int q = 0; q < 4; ++q) { sq[q] += shflx(sq[q], o, lane_l); skv[q] += shflx(skv[q], o, lane_l); }
        }
#pragma unroll
        for (int q = 0; q < 4; ++q) {
            const int t = t0 + q * F.rstep;
            if (lane_l == 0) { rq[t] = rsqrtf(sq[q] * (1.0f / 384.0f) + RMS_EPS); rkv[t] = rsqrtf(skv[q] * (1.0f / 256.0f) + RMS_EPS); }
            if (lane_l < 16) {
                const unsigned a = cvt_pk_bf16(x1[q] * cs[q] - x2[q] * sn[q], x1[q] * sn[q] + x2[q] * cs[q]);
                krope[(size_t)t * 32 + lane_l] = (bf16_t)(a & 0xffffu); krope[(size_t)t * 32 + 16 + lane_l] = (bf16_t)(a >> 16);
            }
        }
    }
    float* ccum = (float*)(F.ws + WS_CCUM);
    LAS float* tot = (LAS float*)(F.lds);
    for (int bh = F.bx; bh < 64; bh += F.G) {
        const int b = bh >> 3, h = bh & 7;
        const float bf = p.in[6][li * 8 + h];
        float v[8]; float carry = 0.f;
#pragma unroll
        for (int j = 0; j < 8; ++j) {
            const int s = 512 * F.wave + 64 * j + lane_l;
            const float xg = bf2f(proj[((size_t)b * SEQ + s) * EIN_NP + C_FG + h]) + bf;
            float ls = (xg >= 0.f) ? -log1pf(expf(-xg)) : (xg - log1pf(expf(xg)));
#pragma unroll
            for (int d = 1; d < 64; d <<= 1) { const float t_ = __int_as_float(__builtin_amdgcn_ds_bpermute(((lane_l - d) & 63) << 2, __float_as_int(ls))); if (lane_l >= d) ls += t_; }
            v[j] = ls + carry;
            carry = __int_as_float(__builtin_amdgcn_readlane(__float_as_int(v[j]), 63));
        }
        __syncthreads();
        if (lane_l == 0) tot[F.wave] = carry;
        __syncthreads();
        float off = 0.f;
#pragma unroll
        for (int w = 0; w < 8; ++w) { const float tw = tot[w]; if (w < F.wave) off += tw; }
#pragma unroll
        for (int j = 0; j < 8; ++j) ccum[(size_t)bh * SEQ + 512 * F.wave + 64 * j + lane_l] = (v[j] + off) * LOG2E;
    }
}

__device__ __forceinline__ void phase_odd_post(const Frame& F, const Params& p, int layer) {
    int tl_ = F.tid; asm volatile("" : "+v"(tl_)); const int lane_l = tl_ & 63;
    const int li = layer >> 1;
    const float linit = 0.8f - 0.6f * expf(-0.3f * (float)layer);
    const float s1 = wave_sum(p.in[13][li * 64 + lane_l] * p.in[14][li * 64 + lane_l], lane_l);
    const float s2 = wave_sum(p.in[15][li * 64 + lane_l] * p.in[16][li * 64 + lane_l], lane_l);
    const float lam = expf(s1) - expf(s2) + linit;
    const bf16_t* Oa = (const bf16_t*)(F.ws + WS_R2); const bf16_t* Ob = (const bf16_t*)(F.ws + WS_R2 + R2_OB);
    bf16_t* outb = F.hnbuf;
    const float* sub = p.in[17] + li * 128 + (16 * lane_l & 127);
    f32x4 sg[4];
#pragma unroll
    for (int j = 0; j < 4; ++j) sg[j] = *(const f32x4*)(sub + 4 * j) * (1.0f - linit);
    for (int row = F.r0; row < F.rend; row += 2 * F.rstep) {
        size_t ro[2]; ro[0] = (size_t)row * 1024 + 16 * lane_l; ro[1] = (size_t)(row + F.rstep) * 1024 + 16 * lane_l;
        u32x4 a0[2], a1[2], b0[2], b1[2];
#pragma unroll
        for (int q = 0; q < 2; ++q) { a0[q] = *(const u32x4*)(Oa + ro[q]); a1[q] = *(const u32x4*)(Oa + ro[q] + 8); b0[q] = *(const u32x4*)(Ob + ro[q]); b1[q] = *(const u32x4*)(Ob + ro[q] + 8); }
#pragma unroll
        for (int q = 0; q < 2; ++q) {
            f32x4 v[4];
            v[0] = (f32x4){bf_lo(a0[q].x) - lam * bf_lo(b0[q].x), bf_hi(a0[q].x) - lam * bf_hi(b0[q].x), bf_lo(a0[q].y) - lam * bf_lo(b0[q].y), bf_hi(a0[q].y) - lam * bf_hi(b0[q].y)};
            v[1] = (f32x4){bf_lo(a0[q].z) - lam * bf_lo(b0[q].z), bf_hi(a0[q].z) - lam * bf_hi(b0[q].z), bf_lo(a0[q].w) - lam * bf_lo(b0[q].w), bf_hi(a0[q].w) - lam * bf_hi(b0[q].w)};
            v[2] = (f32x4){bf_lo(a1[q].x) - lam * bf_lo(b1[q].x), bf_hi(a1[q].x) - lam * bf_hi(b1[q].x), bf_lo(a1[q].y) - lam * bf_lo(b1[q].y), bf_hi(a1[q].y) - lam * bf_hi(b1[q].y)};
            v[3] = (f32x4){bf_lo(a1[q].z) - lam * bf_lo(b1[q].z), bf_hi(a1[q].z) - lam * bf_hi(b1[q].z), bf_lo(a1[q].w) - lam * bf_lo(b1[q].w), bf_hi(a1[q].w) - lam * bf_hi(b1[q].w)};
            float ss = 0.f;
#pragma unroll
            for (int j = 0; j < 4; ++j) ss += v[j][0] * v[j][0] + v[j][1] * v[j][1] + v[j][2] * v[j][2] + v[j][3] * v[j][3];
            ss += shflx(ss, 1, lane_l); ss += shflx(ss, 2, lane_l); ss += shflx(ss, 4, lane_l);
            const float r = rsqrtf(ss * (1.0f / 128.0f) + RMS_EPS);
#pragma unroll
            for (int j = 0; j < 4; ++j) v[j] = v[j] * r * sg[j];
            u32x4 w0, w1;
            w0.x = cvt_pk_bf16(v[0][0], v[0][1]); w0.y = cvt_pk_bf16(v[0][2], v[0][3]); w0.z = cvt_pk_bf16(v[1][0], v[1][1]); w0.w = cvt_pk_bf16(v[1][2], v[1][3]);
            w1.x = cvt_pk_bf16(v[2][0], v[2][1]); w1.y = cvt_pk_bf16(v[2][2], v[2][3]); w1.z = cvt_pk_bf16(v[3][0], v[3][1]); w1.w = cvt_pk_bf16(v[3][2], v[3][3]);
            *(u32x4*)(outb + ro[q]) = w0; *(u32x4*)(outb + ro[q] + 8) = w1;
        }
    }
}

__device__ __forceinline__ void phase_ffn_fix(const Frame& F, const float* cw, const float* cb) {
    const float* halo = (const float*)(F.ws + WS_R2 + R2_HALO); const float* part = (const float*)(F.ws + WS_R2 + R2_PART); const float* val01 = (const float*)(F.ws + WS_R2 + R2_VAL);
    bf16_t* act = (bf16_t*)(F.ws + WS_PROJ);
    constexpr int CG = D_FF / 4, TOT = (MTOK / 64) * 2 * CG;
    const bool byx = (F.G == 256);
    for (int it = (byx ? F.rank : F.bx) * NTHREADS + F.tid; it < (byx ? TOT / 8 : TOT); it += (byx ? 32 : F.G) * NTHREADS) {
        const int cgi = it % CG, rr = (it / CG) & 1, chunk = (byx ? F.xcd * 64 : 0) + it / (2 * CG), col = 4 * cgi;
        const int prev = chunk > 0 ? chunk - 1 : 0; const float hm = (chunk & 63) ? 1.0f : 0.0f;
        f32x4 cv = *(const f32x4*)(part + (size_t)(chunk * 2 + rr) * D_FF + col);
        const f32x4 v = *(const f32x4*)(val01 + (size_t)(chunk * 2 + rr) * D_FF + col);
        const f32x4 h0 = *(const f32x4*)(halo + (size_t)(prev * 2 + 0) * D_FF + col), h1 = *(const f32x4*)(halo + (size_t)(prev * 2 + 1) * D_FF + col);
        const f32x4 w0 = *(const f32x4*)(cw + col), w1 = *(const f32x4*)(cw + D_FF + col);
        const f32x4 add = (rr == 0) ? (w1 * h1 + w0 * h0) : (w0 * h1);
        cv = cv + add * hm;
        u32x2 w; w.x = cvt_pk_bf16(gelu_tanh(cv[0]) * v[0], gelu_tanh(cv[1]) * v[1]); w.y = cvt_pk_bf16(gelu_tanh(cv[2]) * v[2], gelu_tanh(cv[3]) * v[3]);
        *(u32x2*)(act + (size_t)(chunk * 64 + rr) * D_FF + col) = w;
    }
}

__device__ __forceinline__ void phase_attn_even(const Frame& F, const int pm) {
    const bf16_t* proj = (const bf16_t*)(F.ws + WS_PROJ);
    const bf16_t* qmla = (const bf16_t*)(F.ws + WS_R2); const bf16_t* kvmla = (const bf16_t*)(F.ws + WS_R2 + R2_KVMLA);
    const bf16_t* krope = (const bf16_t*)(F.ws + WS_KROPE);
    bf16_t* ao = F.hnbuf;
    const float* ccum = (const float*)(F.ws + WS_CCUM);
    for (int it_ = 0; it_ < (F.G == 256 ? 4 : (1024 + F.G - 1) / F.G); ++it_) {
        int item;
        if (F.G == 256) { const int li = F.rank + 32 * it_; item = (li >> 6) * 512 + (F.xcd * 8 + ((li & 63) >> 3)) * 8 + (li & 7); }
        else { item = F.vcu + it_ * F.G; if (item >= 1024) break; }
        const int stream = item >> 9, rem = item & 511, bh = rem >> 3, pr = rem & 7, b = bh >> 3, h = bh & 7;
        const size_t rowbase = (size_t)b * SEQ;
        AttnP P;
        if (stream == 0) {
            P.Q = proj + C_FQ + h * 64; P.ldq = EIN_NP; P.K1 = proj + C_FK + h * 64; P.ldk1 = EIN_NP; P.K2 = nullptr; P.V = proj + C_FV + h * 64; P.ldv = EIN_NP;
            P.O = ao + h * 64; P.ldo = 1024; P.bias = ccum + (size_t)bh * SEQ; P.sl2 = 0.f; P.Oprev = nullptr; P.subln = nullptr; P.lam = 0.f; P.osc = 0.f;
            attn_unit<64, 64, 0>(F.lds, P, rowbase, 15 - pr, F.tid, pm);
            attn_unit<64, 64, 0>(F.lds, P, rowbase, pr, F.tid, pm);
        } else {
            P.Q = qmla + h * 96; P.ldq = 768; P.K1 = kvmla + h * 128; P.ldk1 = 1024; P.K2 = krope; P.V = kvmla + h * 128 + 64; P.ldv = 1024;
            P.O = ao + 512 + h * 64; P.ldo = 1024; P.bias = nullptr; P.sl2 = 0.f; P.Oprev = nullptr; P.subln = nullptr; P.lam = 0.f; P.osc = 0.f;
            attn_unit<96, 64, 1>(F.lds, P, rowbase, 15 - pr, F.tid, pm);
            attn_unit<96, 64, 1>(F.lds, P, rowbase, pr, F.tid, pm);
        }
    }
}
__device__ __forceinline__ void phase_attn_odd(const Frame& F, const Params& p, const int layer, const int pm) {
    int tid_l = F.tid; asm volatile("" : "+v"(tid_l));
    const int lane_l = tid_l & 63, li_ = layer >> 1;
    const bf16_t* proj = (const bf16_t*)(F.ws + WS_PROJ);
    bf16_t* Oa = (bf16_t*)(F.ws + WS_R2); bf16_t* ao = F.hnbuf;
    const float linit = 0.8f - 0.6f * expf(-0.3f * (float)layer);
    const float s1 = wave_sum(p.in[13][li_ * 64 + lane_l] * p.in[14][li_ * 64 + lane_l], lane_l);
    const float s2 = wave_sum(p.in[15][li_ * 64 + lane_l] * p.in[16][li_ * 64 + lane_l], lane_l);
    const float lam = expf(s1) - expf(s2) + linit;
    for (int it_ = 0; it_ < (F.G == 256 ? 2 : (512 + F.G - 1) / F.G); ++it_) {
        int item;
        if (F.G == 256) { const int li = F.rank + 32 * it_; item = (F.xcd * 8 + (li >> 3)) * 8 + (li & 7); }
        else { item = F.vcu + it_ * F.G; if (item >= 512) break; }
        const int bh = item >> 3, pr = item & 7, b = bh >> 3, h = bh & 7;
        const size_t rowbase = (size_t)b * SEQ;
        for (int half = 0; half < 2; ++half) {
            const int qb = half ? pr : 15 - pr;
            for (int w2 = 0; w2 < 2; ++w2) {
                const int hp = 2 * h + w2;
                AttnP P;
                P.Q = proj + hp * 64; P.ldq = OIN_N; P.K1 = proj + 1024 + hp * 64; P.ldk1 = OIN_N; P.K2 = nullptr; P.V = proj + 2048 + h * 128; P.ldv = OIN_N;
                P.ldo = 1024; P.bias = nullptr; P.sl2 = exp2f(-(float)(h + 1)) * LOG2E;
                P.O = (w2 ? ao : Oa) + h * 128; P.Oprev = w2 ? (const bf16_t*)(Oa + h * 128) : nullptr;
                P.subln = p.in[17] + li_ * 128; P.lam = lam; P.osc = 1.0f - linit;
                attn_unit<64, 128, 2>(F.lds, P, rowbase, qb, tid_l, pm);
            }
        }
    }
}

#ifndef PHMASK
#define PHMASK 0xffff
#endif
#ifndef PROBEMODE
#define PROBEMODE 0
#endif
#ifndef SYNC2
#define SYNC2 0
#endif
#ifndef REPMASK
#define REPMASK 0
#endif
enum { K_PRO = 0, K_GIN = 1, K_ESMALL = 2, K_EGEMM = 3, K_ATTN = 4, K_OPOST = 5, K_GOUT = 6, K_ROWMIX = 7, K_F1 = 8, K_F2 = 9, K_F3 = 10, K_ROWFFN = 11 };
constexpr int NPHASES = 1 + 2 * 18;

__global__ void __launch_bounds__(NTHREADS) mega_kernel(Params p_) {
    extern __shared__ __attribute__((aligned(16))) unsigned char lds_raw[];
    const int ph_lo = p_.ph_lo, ph_hi = p_.ph_hi, coop = p_.coop;
    const int wave_s = __builtin_amdgcn_readfirstlane((int)threadIdx.x >> 6);
    if (coop) {
        volatile LAS unsigned* st_ = (volatile LAS unsigned*)((LAS unsigned char*)lds_raw + 131072 + 64);
        if (threadIdx.x < 4) st_[threadIdx.x] = (threadIdx.x == 3) ? blockIdx.x : 0u;
        __syncthreads();
        (void)xcd_barrier_post((unsigned*)p_.ws, st_);
    } else {
        volatile LAS unsigned* st_ = (volatile LAS unsigned*)((LAS unsigned char*)lds_raw + 131072 + 64);
        if (threadIdx.x == 0) st_[3] = blockIdx.x;
        __syncthreads();
    }
    int rep_done = 0;
    for (int ph = ph_lo; ph < ph_hi; ) {
    const __attribute__((address_space(4))) Params* pp_ = (const __attribute__((address_space(4))) Params*)__builtin_amdgcn_kernarg_segment_ptr(); asm volatile("" : "+s"(pp_));
    const Params& p = *(const Params*)pp_;
    Frame F;
    F.lds = (LAS unsigned char*)lds_raw;
    { int ws_ = wave_s; asm volatile("" : "+s"(ws_)); unsigned z_ = 0u; asm volatile("" : "+s"(z_)); int t_ = ws_ * 64 + (int)__builtin_amdgcn_mbcnt_hi(~0u, __builtin_amdgcn_mbcnt_lo(~0u, z_)); asm volatile("" : "+v"(t_)); F.tid = t_; }
    F.lane = F.tid & 63; F.wave = __builtin_amdgcn_readfirstlane(F.tid >> 6);
    { unsigned a_ = 131072u + 64u + 12u; asm volatile("" : "+v"(a_)); int b_ = __builtin_amdgcn_readfirstlane((int)*(volatile LAS unsigned*)(F.lds + a_)); asm volatile("" : "+s"(b_)); F.bx = b_; }
    F.G = gridDim.x; { const int bx = F.bx; F.vcu = (F.G % 8 == 0) ? (bx % 8) * (F.G / 8) + bx / 8 : bx; }
    F.gw = F.vcu * NWAVES + F.wave; F.NGW = F.G * NWAVES;
    F.xcd = F.bx & 7; F.rank = F.bx >> 3;
    if (F.G == 256) { F.r0 = F.xcd * SEQ + F.rank * NWAVES + F.wave; F.rstep = 256; F.rend = (F.xcd + 1) * SEQ; }
    else { F.r0 = F.gw; F.rstep = F.NGW; F.rend = MTOK; }
    F.ws = p.ws;
    bf16_t* WB = (bf16_t*)(F.ws + WS_W);
    F.hnbuf = (bf16_t*)p.out;
    bf16_t* hn = F.hnbuf;
    bf16_t* xb = (bf16_t*)(F.ws + WS_HN);
    bf16_t* proj = (bf16_t*)(F.ws + WS_PROJ);
    bf16_t* r2 = (bf16_t*)(F.ws + WS_R2);
        int layer = 0, kind = K_PRO;
        if (ph > 0) { const int r = ph - 1, pi = r / 18, rr = r % 18; const bool odd = rr >= 10; layer = 2 * pi + (odd ? 1 : 0); const int idx = odd ? rr - 10 : rr;
            kind = odd ? (idx == 0 ? K_GIN : idx == 1 ? K_ATTN : idx + 4) : (idx < 4 ? idx + 1 : idx + 2); }
        const int li = layer >> 1; const bool oddl = layer & 1;
        const int pm_ = (PROBEMODE && !rep_done) ? PROBEMODE : 0;
        if (kind == K_PRO) {
            if (PHMASK & 1) phase_prologue(F, p);
        } else if (kind == K_GIN || kind == K_GOUT || kind == K_F3) {
            pg8::Gemm g; EpiStore E; E.rowscale = nullptr; E.rs_mul = 1.f; E.ropec = nullptr; E.ropes = nullptr; E.s0 = 0.125f * LOG2E; E.scale_cols = 0;
            if (kind == K_GIN) {
                if (!oddl) { g = pg8::Gemm{hn, WB + OW_EIN + (size_t)li * EIN_NP * 1024, MTOK, EIN_NP, 1024, 1024, 1024}; E.O = proj; E.ldc = EIN_NP; E.scale_cols = 512; }
                else { g = pg8::Gemm{hn, WB + OW_OIN + (size_t)li * OIN_N * 1024, MTOK, OIN_N, 1024, 1024, 1024}; E.O = proj; E.ldc = OIN_N; E.scale_cols = 1024; }
            } else if (kind == K_GOUT) {
                g = pg8::Gemm{hn, WB + (oddl ? OW_OOUT : OW_EOUT) + (size_t)li * 1024 * 1024, MTOK, 1024, 1024, 1024, 1024}; E.O = r2; E.ldc = 1024;
            } else {
                g = pg8::Gemm{proj, WB + OW_DN + (size_t)layer * 1024 * D_FF, MTOK, 1024, D_FF, D_FF, D_FF}; E.O = r2; E.ldc = 1024;
            }
            pg8::StaticOrder S; S.init(g.M, g.N, F.G, F.bx);
            if (PHMASK & 2) pg8::gemm_phase<EpiStore, pg8::StaticOrder, true>(F.lds, g, S, E, F.tid);
        } else if (kind == K_ESMALL) {
            if (PHMASK & 4) phase_even_small(F, p, li);
        } else if (kind == K_EGEMM) {
            for (int which = 0; which < 2; ++which) {
                pg8::Gemm g; EpiStore E; E.scale_cols = 0; E.s0 = 1.f;
                if (which == 0) { g = pg8::Gemm{proj + C_CQ, WB + OW_EUQ + (size_t)li * 768 * 384, MTOK, 768, 384, EIN_NP, 384};
                    E.O = r2; E.ldc = 768; E.rowscale = (const float*)(F.ws + WS_RSTDQ); E.rs_mul = 0.10206207261596577f * LOG2E; E.ropec = (const float*)(F.ws + WS_COS); E.ropes = (const float*)(F.ws + WS_SIN); }
                else { g = pg8::Gemm{proj + C_CKV, WB + OW_EUKV + (size_t)li * 1024 * 256, MTOK, 1024, 256, EIN_NP, 256};
                    E.O = (bf16_t*)(F.ws + WS_R2 + R2_KVMLA); E.ldc = 1024; E.rowscale = (const float*)(F.ws + WS_RSTDKV); E.rs_mul = 1.f; E.ropec = nullptr; E.ropes = nullptr; }
                pg8::StaticOrder S; S.init(g.M, g.N, F.G, F.bx);
                if (PHMASK & 8) pg8::gemm_phase<EpiStore, pg8::StaticOrder, true>(F.lds, g, S, E, F.tid);
            }
        } else if (kind == K_ATTN) {
            if (!oddl) { if (PHMASK & 16) phase_attn_even(F, pm_); } else { if (PHMASK & 32) phase_attn_odd(F, p, layer, pm_); }
        } else if (kind == K_OPOST) {
            if (PHMASK & 64) phase_odd_post(F, p, layer);
        } else if (kind == K_ROWMIX) {
            if (layer == 0) phase_rowpost<true, false>(F, r2, p.in[0], xb, p.in[2] + layer * 1024, p.in[3] + layer * 1024, hn);
            else phase_rowpost<false, false>(F, r2, xb, xb, p.in[2] + layer * 1024, p.in[3] + layer * 1024, hn);
        } else if (kind == K_F1) {
            pg8::Gemm g{hn, WB + OW_UP + (size_t)layer * 5632 * 1024, MTOK, 2 * D_FF, 1024, 1024, 1024};
            EpiConv E{proj, p.in[20] + (size_t)layer * 3 * D_FF, p.in[21] + (size_t)layer * D_FF, (float*)(F.ws + WS_R2 + R2_HALO), (float*)(F.ws + WS_R2 + R2_PART), (float*)(F.ws + WS_R2 + R2_VAL)};
            pg8::StaticOrder S; S.init(g.M, g.N, F.G, F.bx);
            if (PHMASK & 256) pg8::gemm_phase<EpiConv, pg8::StaticOrder, true>(F.lds, g, S, E, F.tid);
        } else if (kind == K_F2) {
            if (PHMASK & 512) phase_ffn_fix(F, p.in[20] + (size_t)layer * 3 * D_FF, p.in[21] + (size_t)layer * D_FF);
        } else if (kind == K_ROWFFN) {
            if (layer + 1 < DEPTH) phase_rowpost<false, false>(F, r2, xb, xb, p.in[4] + layer * 1024, p.in[1] + (layer + 1) * 1024, hn);
            else phase_rowpost<false, true>(F, r2, xb, p.out, p.in[4] + layer * 1024, nullptr, hn);
        }
        if (coop && ph + 1 < ph_hi) {
            if (ph == 0) {
                cg::this_grid().sync();
                volatile LAS unsigned* st_ = (volatile LAS unsigned*)(F.lds + 131072 + 64);
                if (threadIdx.x == 0) {
                    unsigned* bar_ = (unsigned*)F.ws; bool ok_ = (gridDim.x % 8u) == 0u;
                    for (unsigned j = 0; j < 16; ++j) { const unsigned c_ = xb_ld(&bar_[XB_XCNT(j)]); ok_ = ok_ && (c_ == (j < 8u ? gridDim.x / 8u : 0u)); }
                    const unsigned x_ = xb_xcc_id();
                    st_[3] = (ok_ && x_ < 8u && st_[2] < gridDim.x / 8u) ? (st_[2] * 8u + x_) : blockIdx.x;
                }
                __syncthreads();
            }
            else { XcdBarrier xb_; xb_.bar = (unsigned*)F.ws; xb_.x = xb_xcc_id(); xb_.st = (volatile LAS unsigned*)(F.lds + 131072 + 64); xcd_barrier(xb_); if (SYNC2) xcd_barrier(xb_); }
        }
        if (((REPMASK >> kind) & 1) && !rep_done) { rep_done = 1; } else { rep_done = 0; ++ph; }
    }
}

#ifndef MK_MULTI
#define MK_MULTI 0
#endif

extern "C" void kernel_launch(void* const* d_in, const int* in_sizes, int n_in, void* d_out, int out_size, void* d_ws, size_t ws_size, hipStream_t stream) {
    static int grid = 0;
    if (grid == 0) {
        if (n_in != 23 || out_size != MTOK * D_MODEL || ws_size < WS_END) { fprintf(stderr, "kernel_launch: unexpected shapes (n_in %d out %d ws %zu need %zu)\n", n_in, out_size, ws_size, (size_t)WS_END); grid = -1; return; }
        int dev = 0, cus = 0, per_cu = 0;
        hipGetDevice(&dev); hipDeviceGetAttribute(&cus, hipDeviceAttributeMultiprocessorCount, dev);
        if (hipFuncSetAttribute((const void*)mega_kernel, hipFuncAttributeMaxDynamicSharedMemorySize, LDS_BYTES) != hipSuccess) { fprintf(stderr, "kernel_launch: hipFuncSetAttribute failed\n"); grid = -1; return; }
        hipOccupancyMaxActiveBlocksPerMultiprocessor(&per_cu, (const void*)mega_kernel, NTHREADS, LDS_BYTES);
        (void)hipGetLastError();
        if (per_cu < 1) fprintf(stderr, "kernel_launch: occupancy query says %d blocks/CU\n", per_cu);
        grid = cus;
    }
    if (grid < 0) return;
    Params p{};
    for (int i = 0; i < 23; ++i) p.in[i] = (const float*)d_in[i];
    p.out = (float*)d_out; p.ws = (unsigned char*)d_ws;
#if MK_MULTI
    for (int ph = 0; ph < NPHASES; ++ph) {
        p.ph_lo = ph; p.ph_hi = ph + 1; p.coop = 0;
        hipLaunchKernelGGL(mega_kernel, dim3(grid), dim3(NTHREADS), LDS_BYTES, stream, p);
    }
#else
    if (hipMemsetAsync(d_ws, 0, 65536, stream) != hipSuccess) { fprintf(stderr, "memset failed\n"); return; }
    p.ph_lo = 0; p.ph_hi = NPHASES; p.coop = 1;
    void* args[] = {&p};
    hipError_t e = hipLaunchCooperativeKernel((const void*)mega_kernel, dim3(grid), dim3(NTHREADS), args, LDS_BYTES, stream);
    if (e != hipSuccess) fprintf(stderr, "cooperative launch failed: %s (grid %d)\n", hipGetErrorString(e), grid);
#endif
}
```
